# Optimizing an MI355X kernel written in HIP

```python
import math
import jax, jax.numpy as jnp
from jax import lax
import numpy as np

D_MODEL = 1024
BATCH = 8
SEQ = 4096
DEPTH = 4
DEC_BATCH = 8
DEC_SEQ = 64
PAST_LEN = 4096

CHUNK = 64
N_HEADS = 16
N_KV_HEADS = 2
HEAD_DIM = 64
GQA_GROUP = N_HEADS // N_KV_HEADS
QKV_DIM = (N_HEADS + 2 * N_KV_HEADS) * HEAD_DIM
WINDOW = 128
WIN_CHUNKS = WINDOW // CHUNK
ROPE_THETA = 10000.0
SSM_GROUP = 16
SSM_GROUPS = D_MODEL // SSM_GROUP
SSM_STATE = 64
D_FF = -(-8 * D_MODEL // (3 * 256)) * 256
N_ATTN_LAYERS = (DEPTH + 1) // 2
N_SSM_LAYERS = DEPTH // 2
DN_ALPHA = (2.0 * DEPTH) ** 0.25
DN_BETA = (8.0 * DEPTH) ** -0.25
LN_EPS = 1e-5
NEG_INF = -1e30

kernel_name = "hybrid_swa_s5_streaming_step"


def layer_norm(x, g, b):
    xf = x.astype(jnp.float32)
    mu = xf.mean(-1, keepdims=True)
    var = jnp.square(xf - mu).mean(-1, keepdims=True)
    y = (xf - mu) * lax.rsqrt(var + LN_EPS) * g.astype(jnp.float32) + b.astype(jnp.float32)
    return y.astype(x.dtype)


def rope(x, pos):
    half = HEAD_DIM // 2
    inv = ROPE_THETA ** (-jnp.arange(half, dtype=jnp.float32) / half)
    ang = pos.astype(jnp.float32)[:, None] * inv[None, :]
    cos = jnp.cos(ang)[None, :, None, :]
    sin = jnp.sin(ang)[None, :, None, :]
    xf = x.astype(jnp.float32)
    x1, x2 = xf[..., :half], xf[..., half:]
    return jnp.concatenate([x1 * cos - x2 * sin, x2 * cos + x1 * sin], axis=-1).astype(x.dtype)


def sink_softmax(s, sink):
    m = jnp.maximum(s.max(-1, keepdims=True), sink)
    e = jnp.exp(s - m)
    return e / (e.sum(-1, keepdims=True) + jnp.exp(sink - m))


def qkv_proj(x, w_qkv, b_qkv, pos):
    B, T, _ = x.shape
    qkv = x @ w_qkv + b_qkv
    nq = N_HEADS * HEAD_DIM
    nk = N_KV_HEADS * HEAD_DIM
    q = rope(qkv[..., :nq].reshape(B, T, N_HEADS, HEAD_DIM), pos)
    k = rope(qkv[..., nq:nq + nk].reshape(B, T, N_KV_HEADS, HEAD_DIM), pos)
    v = qkv[..., nq + nk:].reshape(B, T, N_KV_HEADS, HEAD_DIM)
    return q.reshape(B, T, N_KV_HEADS, GQA_GROUP, HEAD_DIM), k, v


def attn_prompt(x, w_qkv, b_qkv, sinks, w_o, b_o):
    B, S, _ = x.shape
    NC = S // CHUNK
    q, k, v = qkv_proj(x, w_qkv, b_qkv, jnp.arange(S))
    pad = ((0, 0), (WIN_CHUNKS * CHUNK, 0), (0, 0), (0, 0))
    kc = jnp.pad(k, pad).reshape(B, NC + WIN_CHUNKS, CHUNK, N_KV_HEADS, HEAD_DIM)
    vc = jnp.pad(v, pad).reshape(B, NC + WIN_CHUNKS, CHUNK, N_KV_HEADS, HEAD_DIM)
    kb = jnp.concatenate([kc[:, j:j + NC] for j in range(WIN_CHUNKS + 1)], axis=2)
    vb = jnp.concatenate([vc[:, j:j + NC] for j in range(WIN_CHUNKS + 1)], axis=2)
    key_pos = (jnp.arange(NC)[:, None] - WIN_CHUNKS) * CHUNK + jnp.arange((WIN_CHUNKS + 1) * CHUNK)[None, :]
    qb = q.reshape(B, NC, CHUNK, N_KV_HEADS, GQA_GROUP, HEAD_DIM)
    s = jnp.einsum('bnqkgd,bnpkd->bnkgqp', qb, kb).astype(jnp.float32) * (HEAD_DIM ** -0.5)
    s = jnp.where((key_pos >= 0)[None, :, None, None, None, :], s, NEG_INF)
    p = sink_softmax(s, sinks.astype(jnp.float32).reshape(1, 1, N_KV_HEADS, GQA_GROUP, 1, 1))
    o = jnp.einsum('bnkgqp,bnpkd->bnqkgd', p.astype(vb.dtype), vb).reshape(B, S, N_HEADS * HEAD_DIM)
    y = o @ w_o + b_o
    return y, k[:, S - WINDOW:], v[:, S - WINDOW:]


def attn_sample(x, ck, cv, w_qkv, b_qkv, sinks, w_o, b_o):
    B, T, _ = x.shape
    R = ck.shape[1]
    q, k, v = qkv_proj(x, w_qkv, b_qkv, PAST_LEN + jnp.arange(T))
    kk = jnp.concatenate([ck.astype(k.dtype), k], axis=1)
    vv = jnp.concatenate([cv.astype(v.dtype), v], axis=1)
    s = jnp.einsum('btkgd,bpkd->bkgtp', q, kk).astype(jnp.float32) * (HEAD_DIM ** -0.5)
    p = sink_softmax(s, sinks.astype(jnp.float32).reshape(1, N_KV_HEADS, GQA_GROUP, 1, 1))
    o = jnp.einsum('bkgtp,bpkd->btkgd', p.astype(vv.dtype), vv).reshape(B, T, N_HEADS * HEAD_DIM)
    y = o @ w_o + b_o
    return y, kk[:, -R:], vv[:, -R:]


def s5_discretize(log_dt, a_re, a_im, b_re, b_im, c_re, c_im):
    dt = jnp.exp(log_dt.astype(jnp.float32))[:, None]
    a = lax.complex(a_re.astype(jnp.float32), a_im.astype(jnp.float32))
    a_bar = jnp.exp(dt * a)
    bmat = lax.complex(b_re.astype(jnp.float32), b_im.astype(jnp.float32))
    b_bar = ((a_bar - 1.0) / a)[..., None] * bmat
    c = lax.complex(c_re.astype(jnp.float32), c_im.astype(jnp.float32))
    return a_bar, b_bar, c


def _lin_combine(e1, e2):
    a1, b1 = e1
    a2, b2 = e2
    return a1 * a2, a2 * b1 + b2


def s5_block_scan(u, s0, a_bar, b_bar, c):
    bu = jnp.einsum('gpc,blgc->blgp', b_bar, u.astype(jnp.complex64))
    bu = bu.at[:, 0].add(a_bar * s0)
    a = jnp.broadcast_to(a_bar, bu.shape)
    _, s = lax.associative_scan(_lin_combine, (a, bu), axis=1)
    y = jnp.einsum('gcp,blgp->blgc', c, s).real
    return y, s[:, -1]


def s5_glu(x, u, y, d, w_glu, b_glu):
    B, T, _ = x.shape
    y = y.reshape(B, T, D_MODEL) + d.astype(jnp.float32) * u
    z = jax.nn.gelu(y)
    gv = z @ w_glu.astype(jnp.float32) + b_glu.astype(jnp.float32)
    return (gv[..., :D_MODEL] * jax.nn.sigmoid(gv[..., D_MODEL:])).astype(x.dtype)


def ssm_prompt(x, w_in, b_in, log_dt, a_re, a_im, b_re, b_im, c_re, c_im, d, w_glu, b_glu):
    B, S, _ = x.shape
    NC = S // CHUNK
    a_bar, b_bar, c = s5_discretize(log_dt, a_re, a_im, b_re, b_im, c_re, c_im)
    u = (x @ w_in + b_in).astype(jnp.float32)
    uc = u.reshape(B, NC, CHUNK, SSM_GROUPS, SSM_GROUP).transpose(1, 0, 2, 3, 4)
    s0 = jnp.zeros((B, SSM_GROUPS, SSM_STATE), jnp.complex64)

    def step(s, u_chunk):
        y_chunk, s_new = s5_block_scan(u_chunk, s, a_bar, b_bar, c)
        return s_new, y_chunk

    s_last, ys = lax.scan(step, s0, uc)
    y = ys.transpose(1, 0, 2, 3, 4)
    return s5_glu(x, u, y, d, w_glu, b_glu), s_last.real, s_last.imag


def ssm_sample(x, st_re, st_im, w_in, b_in, log_dt, a_re, a_im, b_re, b_im, c_re, c_im, d, w_glu, b_glu):
    B, T, _ = x.shape
    a_bar, b_bar, c = s5_discretize(log_dt, a_re, a_im, b_re, b_im, c_re, c_im)
    u = (x @ w_in + b_in).astype(jnp.float32)
    s0 = lax.complex(st_re.astype(jnp.float32), st_im.astype(jnp.float32))
    y, s_last = s5_block_scan(u.reshape(B, T, SSM_GROUPS, SSM_GROUP), s0, a_bar, b_bar, c)
    return s5_glu(x, u, y, d, w_glu, b_glu), s_last.real, s_last.imag


def swiglu(x, w_up, w_down):
    h = x @ w_up
    return (jax.nn.silu(h[..., :D_FF]) * h[..., D_FF:]) @ w_down


def setup_inputs(seed: int = 0) -> dict:
    key = jax.random.key(seed)
    ks = jax.random.split(key, 32)
    f32 = jnp.float32

    def nrm(k, shape, scale):
        return jax.random.normal(k, shape, f32) * scale

    cache_rows = min(WINDOW, PAST_LEN)
    n_idx = jnp.arange(SSM_STATE, dtype=f32)
    return {
        "x_prompt": nrm(ks[0], (BATCH, SEQ, D_MODEL), 1.0),
        "x_sample": nrm(ks[1], (DEC_BATCH, DEC_SEQ, D_MODEL), 1.0),
        "cache_k": nrm(ks[2], (N_ATTN_LAYERS, DEC_BATCH, cache_rows, N_KV_HEADS, HEAD_DIM), 1.0),
        "cache_v": nrm(ks[3], (N_ATTN_LAYERS, DEC_BATCH, cache_rows, N_KV_HEADS, HEAD_DIM), 1.0),
        "state_ssm_re": nrm(ks[4], (N_SSM_LAYERS, DEC_BATCH, SSM_GROUPS, SSM_STATE), 0.1),
        "state_ssm_im": nrm(ks[5], (N_SSM_LAYERS, DEC_BATCH, SSM_GROUPS, SSM_STATE), 0.1),
        "attn_w_qkv": nrm(ks[6], (N_ATTN_LAYERS, D_MODEL, QKV_DIM), D_MODEL ** -0.5),
        "attn_b_qkv": nrm(ks[7], (N_ATTN_LAYERS, QKV_DIM), 0.02),
        "attn_sinks": nrm(ks[8], (N_ATTN_LAYERS, N_HEADS), 0.5),
        "attn_w_o": nrm(ks[9], (N_ATTN_LAYERS, N_HEADS * HEAD_DIM, D_MODEL), (N_HEADS * HEAD_DIM) ** -0.5 * DN_BETA),
        "attn_b_o": nrm(ks[10], (N_ATTN_LAYERS, D_MODEL), 0.02),
        "ssm_w_in": nrm(ks[11], (N_SSM_LAYERS, D_MODEL, D_MODEL), D_MODEL ** -0.5),
        "ssm_b_in": nrm(ks[12], (N_SSM_LAYERS, D_MODEL), 0.02),
        "ssm_log_dt": jax.random.uniform(ks[13], (N_SSM_LAYERS, SSM_GROUPS), f32, math.log(1e-3), math.log(1e-1)),
        "ssm_a_re": -0.5 + nrm(ks[14], (N_SSM_LAYERS, SSM_GROUPS, SSM_STATE), 0.01),
        "ssm_a_im": jnp.pi * n_idx + nrm(ks[15], (N_SSM_LAYERS, SSM_GROUPS, SSM_STATE), 0.01),
        "ssm_b_re": nrm(ks[16], (N_SSM_LAYERS, SSM_GROUPS, SSM_STATE, SSM_GROUP), (2.0 * SSM_GROUP) ** -0.5),
        "ssm_b_im": nrm(ks[17], (N_SSM_LAYERS, SSM_GROUPS, SSM_STATE, SSM_GROUP), (2.0 * SSM_GROUP) ** -0.5),
        "ssm_c_re": nrm(ks[18], (N_SSM_LAYERS, SSM_GROUPS, SSM_GROUP, SSM_STATE), 0.5),
        "ssm_c_im": nrm(ks[19], (N_SSM_LAYERS, SSM_GROUPS, SSM_GROUP, SSM_STATE), 0.5),
        "ssm_d": nrm(ks[20], (N_SSM_LAYERS, D_MODEL), 1.0),
        "ssm_w_glu": jnp.concatenate([
            nrm(ks[21], (N_SSM_LAYERS, D_MODEL, D_MODEL), D_MODEL ** -0.5 * DN_BETA),
            nrm(ks[22], (N_SSM_LAYERS, D_MODEL, D_MODEL), D_MODEL ** -0.5)], axis=-1),
        "ssm_b_glu": nrm(ks[23], (N_SSM_LAYERS, 2 * D_MODEL), 0.02),
        "ffn_w_up": nrm(ks[24], (DEPTH, D_MODEL, 2 * D_FF), D_MODEL ** -0.5),
        "ffn_w_down": nrm(ks[25], (DEPTH, D_FF, D_MODEL), D_FF ** -0.5 * DN_BETA),
        "ln_gain": 1.0 + nrm(ks[26], (DEPTH, 2, D_MODEL), 0.02),
        "ln_bias": nrm(ks[27], (DEPTH, 2, D_MODEL), 0.02),
    }


def reference(x_prompt, x_sample, cache_k, cache_v, state_ssm_re, state_ssm_im,
              attn_w_qkv, attn_b_qkv, attn_sinks, attn_w_o, attn_b_o,
              ssm_w_in, ssm_b_in, ssm_log_dt, ssm_a_re, ssm_a_im, ssm_b_re, ssm_b_im,
              ssm_c_re, ssm_c_im, ssm_d, ssm_w_glu, ssm_b_glu,
              ffn_w_up, ffn_w_down, ln_gain, ln_bias):
    xp, xs = x_prompt, x_sample
    pk, pv, pre, pim = [], [], [], []
    sk, sv, sre, sim = [], [], [], []
    for i in range(DEPTH):
        l = i // 2
        if i % 2 == 0:
            mp, k_p, v_p = attn_prompt(xp, attn_w_qkv[l], attn_b_qkv[l], attn_sinks[l], attn_w_o[l], attn_b_o[l])
            ms, k_s, v_s = attn_sample(xs, cache_k[l], cache_v[l], attn_w_qkv[l], attn_b_qkv[l],
                                       attn_sinks[l], attn_w_o[l], attn_b_o[l])
            pk.append(k_p); pv.append(v_p); sk.append(k_s); sv.append(v_s)
        else:
            ssm_args = (ssm_w_in[l], ssm_b_in[l], ssm_log_dt[l], ssm_a_re[l], ssm_a_im[l],
                        ssm_b_re[l], ssm_b_im[l], ssm_c_re[l], ssm_c_im[l], ssm_d[l],
                        ssm_w_glu[l], ssm_b_glu[l])
            mp, r_p, i_p = ssm_prompt(xp, *ssm_args)
            ms, r_s, i_s = ssm_sample(xs, state_ssm_re[l], state_ssm_im[l], *ssm_args)
            pre.append(r_p); pim.append(i_p); sre.append(r_s); sim.append(i_s)
        xp = layer_norm(DN_ALPHA * xp + mp, ln_gain[i, 0], ln_bias[i, 0])
        xs = layer_norm(DN_ALPHA * xs + ms, ln_gain[i, 0], ln_bias[i, 0])
        xp = layer_norm(DN_ALPHA * xp + swiglu(xp, ffn_w_up[i], ffn_w_down[i]), ln_gain[i, 1], ln_bias[i, 1])
        xs = layer_norm(DN_ALPHA * xs + swiglu(xs, ffn_w_up[i], ffn_w_down[i]), ln_gain[i, 1], ln_bias[i, 1])
    return (xp, xs,
            jnp.stack(pk), jnp.stack(pv), jnp.stack(pre), jnp.stack(pim),
            jnp.stack(sk), jnp.stack(sv), jnp.stack(sre), jnp.stack(sim))
```

```cpp
#include <hip/hip_runtime.h>
#include <hip/hip_cooperative_groups.h>
#include <cstdio>
#include <cstdint>
namespace cg = cooperative_groups;

#define LAS __attribute__((address_space(3)))
typedef unsigned short bf16_t;
typedef short bf16x8 __attribute__((ext_vector_type(8)));
typedef float f32x4 __attribute__((ext_vector_type(4)));
typedef float f32x2 __attribute__((ext_vector_type(2)));
typedef unsigned u32x4 __attribute__((ext_vector_type(4)));
typedef unsigned u32x2 __attribute__((ext_vector_type(2)));

constexpr int D = 1024, MP = 32768, MS = 512, MT = MP + MS, NQKV = 1280, DFF = 2816, NUP = 2 * DFF;
constexpr int NBC = 520;
constexpr int KT = 1152;
constexpr float ALPHA = 1.6817928305074290f;
constexpr float LN_EPS = 1e-5f;

enum { I_XP = 0, I_XS, I_CK, I_CV, I_SRE, I_SIM, I_WQKV, I_BQKV, I_SINK, I_WO, I_BO, I_WIN, I_BIN, I_LOGDT, I_ARE, I_AIM, I_BRE, I_BIM, I_CRE, I_CIM,
       I_SD, I_WGLU, I_BGLU, I_WUP, I_WDN, I_LNG, I_LNB, N_IN };

constexpr size_t O_YS = 33554432, O_KP = 34078720, O_VP = 34340864, O_REP = 34603008, O_IMP = 34668544, O_KSM = 34734080, O_VSM = 34996224,
                 O_RES = 35258368, O_IMS = 35323904;

constexpr size_t MiB = 1u << 20;
constexpr size_t WS_WQKV = 0, WS_WO = 5 * MiB, WS_WIN = 9 * MiB, WS_WGLU = 13 * MiB, WS_WUP = 21 * MiB, WS_WDN = 65 * MiB;
constexpr size_t WS_XN = 87 * MiB, WS_H = 152 * MiB;
constexpr size_t WS_Q = WS_H, WS_O = WS_H + 65 * MiB, WS_K = WS_H + 130 * MiB, WS_V = WS_H + 138 * MiB;
constexpr size_t WS_U = WS_H, WS_ZG = WS_H + 74 * MiB, WS_DS = WS_H + 139 * MiB;
constexpr size_t WS_T = 331 * MiB, WS_W1T = 475 * MiB, WS_KTAB = 492 * MiB, WS_LAMP = 496 * MiB, WS_BB = 501 * MiB, WS_ROPE = 502 * MiB, WS_KS = 504 * MiB,
                 WS_VS = 505 * MiB, WS_END = 506 * MiB;

__device__ __forceinline__ unsigned cvt_pk_bf16(float lo, float hi) { unsigned r; asm volatile("v_cvt_pk_bf16_f32 %0, %1, %2" : "=v"(r) : "v"(lo), "v"(hi)); return r; }
__device__ __forceinline__ int my_lane() { int l; asm volatile("v_mbcnt_lo_u32_b32 %0, -1, 0\n\tv_mbcnt_hi_u32_b32 %0, -1, %0" : "=v"(l)); return l; }
__device__ __forceinline__ float bf2f(unsigned short b) { return __uint_as_float((unsigned)b << 16); }
__device__ __forceinline__ float bflo(unsigned w) { return __uint_as_float(w << 16); }
__device__ __forceinline__ float bfhi(unsigned w) { return __uint_as_float(w & 0xffff0000u); }

namespace pg8 {
constexpr int BM = 256, BK = 64, HALF = 128, HTB = HALF * BK * 2, STAGE_BYTES = 8 * HTB, NXCD = 8, WGM = 8;
__host__ __device__ __forceinline__ int lds_byte(int r, int c) { const int st = (r >> 4) * 2 + (c >> 5), rr = r & 15, cc = c & 31, ob = rr * 64 + cc * 2; return st * 1024 + (ob ^ (((ob >> 9) & 1) << 5)); }
__host__ __device__ __forceinline__ void stage_rc(int b, int& R, int& C) { const int st = b / 1024, sb = b % 1024, swz = sb ^ (((sb >> 9) & 1) << 5); R = (st >> 1) * 16 + swz / 64; C = (st & 1) * 32 + (swz % 64) / 2; }
__host__ __device__ __forceinline__ int perm32(int rho) { const int n = rho >> 4, i = rho & 15; return 8 * (i >> 2) + 4 * n + (i & 3); }

struct Unit { int pm, pn, pg, kt0, nt; };
struct Gemm { const bf16_t* A; const bf16_t* Bt; int K, lda, ldb; size_t gsA, gsB; };

struct StaticOrder {
    int nM, nN, nwg, G, c;
    __device__ __forceinline__ void init(int M, int N, int G_, int c_) { nM = M / BM; nN = N / BM; nwg = nM * nN; G = G_; c = c_; }
    __device__ __forceinline__ bool next(int i, Unit& u) const {
        const long L = (long)i * G + c; if (L >= nwg) return false;
        int wgid = (int)L; { const int q = nwg / NXCD, r = nwg % NXCD, xcd = wgid % NXCD, off = wgid / NXCD; wgid = (xcd < r ? xcd * (q + 1) : r * (q + 1) + (xcd - r) * q) + off; }
        const int nig = WGM * nN, gid = wgid / nig, fm = gid * WGM, gsz = (nM - fm) < WGM ? (nM - fm) : WGM;
        u.pm = fm + ((wgid % nig) % gsz); u.pn = (wgid % nig) / gsz; u.pg = 0; u.kt0 = 0; u.nt = 0; return true;
    }
};
struct GroupOrder {
    int nM, nN, per, total, G, vc, tri;
    __device__ __forceinline__ void init(int nM_, int nN_, int ngroups, int G_, int c_, int tri_) { nM = nM_; nN = nN_; per = nM_ * nN_; total = per * ngroups; G = G_; tri = tri_; vc = (G_ % 8 == 0) ? (c_ % 8) * (G_ / 8) + c_ / 8 : c_; }
    __device__ __forceinline__ bool next(int i, Unit& u) const {
        const int L = i * G + vc; if (L >= total) return false;
        u.pg = L / per; const int r = L % per; u.pm = r / nN; u.pn = r % nN; u.kt0 = 0; u.nt = 0;
        if (tri) { const int p = u.pn, rr = i % 3; u.pn = rr == 0 ? p : (rr == 1 ? ((p + 2) & 3) : ((0x1203 >> (4 * p)) & 3)); u.nt = 2 + 4 * (u.pn + 1); }
        return true;
    }
};

struct PanelOrder {
    int nN, total, G, vc;
    __device__ __forceinline__ void init(int M, int N, int G_, int c_) { nN = N / BM; total = (M / BM) * nN; G = G_; vc = (G_ % 8 == 0) ? (c_ % 8) * (G_ / 8) + c_ / 8 : c_; }
    __device__ __forceinline__ bool next(int i, Unit& u) const {
        const int L = i * G + vc; if (L >= total) return false;
        u.pg = 0; u.pm = L / nN; u.pn = L % nN; u.kt0 = 0; u.nt = 0; return true;
    }
};
struct PrefixOrder {
    StaticOrder base; int has, pm, pn;
    __device__ __forceinline__ bool next(int i, Unit& u) const {
        if (has) { if (i == 0) { u.pm = pm; u.pn = pn; u.pg = 0; u.kt0 = 0; u.nt = 0; return true; } return base.next(i - 1, u); }
        return base.next(i, u);
    }
};
struct OneUnit { int pm, pn; __device__ __forceinline__ bool next(int i, Unit& u) const { if (i > 0) return false; u.pm = pm; u.pn = pn; u.pg = 0; u.kt0 = 0; u.nt = 0; return true; } };
template <class Epi, class Sched>
__device__ __forceinline__ void gemm_phase(LAS unsigned char* lds, const Gemm g_in, const Sched& S, const Epi& E, int wave_s) {
    Gemm g = g_in;
    int tid = wave_s * 64 + my_lane();
    asm volatile("" : "+v"(tid));
    asm volatile("" : "+s"(g.K), "+s"(g.lda), "+s"(g.ldb));
    asm volatile("" : "+s"(g.A), "+s"(g.Bt));
    const int wid = __builtin_amdgcn_readfirstlane(tid >> 6), lane = tid & 63, wr = wid >> 2, wc = wid & 3, fr = lane & 15, fq = lane >> 4;
    const int K = g.K, nt_all = K / BK;
    unsigned voffA, voffB;
    { int R, C; stage_rc(tid * 16, R, C); const int Rb = ((R & ~31) + perm32(R & 31)); voffA = (unsigned)(R * g.lda + C) * 2u; voffB = (unsigned)(Rb * g.ldb + C) * 2u; }
    const size_t kstep = (size_t)(BK * 2);
    const size_t hstepA = (size_t)HALF * g.lda * 2, hstepB = (size_t)HALF * g.ldb * 2;
    const size_t tstepA = 2 * hstepA, tstepB = 2 * hstepB, qvoffA = hstepA / 2, qvoffB = hstepB / 2;
    const unsigned ldsw = (unsigned)wid * 1024u;
    const int aoff = lds_byte(wr * 64 + fr, fq * 8), boff = lds_byte(wc * 32 + fr, fq * 8);
#define PG8_SA(b, h) (((b) * 2 + (h)) * HTB)
#define PG8_SB(b, h) ((4 + (b) * 2 + (h)) * HTB)
#define PG8_STAGE(bufoff, gbase, voff) do { \
        __builtin_amdgcn_global_load_lds((const unsigned*)((const char*)(gbase) + (voff)), (LAS unsigned*)(lds + (bufoff) + ldsw), 16, 0, 0); \
        __builtin_amdgcn_global_load_lds((const unsigned*)((const char*)(gbase) + q##voff + (voff)), (LAS unsigned*)(lds + (bufoff) + ldsw + 8192), 16, 0, 0); } while (0)
#define PG8_LDA(dst, b, h) do { _Pragma("unroll") for (int m = 0; m < 4; ++m) _Pragma("unroll") for (int k = 0; k < 2; ++k) dst[m][k] = *(const LAS bf16x8*)(lds + PG8_SA(b, h) + aoff + m * 2048 + k * 1024); } while (0)
#define PG8_LDB(dst, b, h) do { _Pragma("unroll") for (int n = 0; n < 2; ++n) _Pragma("unroll") for (int k = 0; k < 2; ++k) dst[n][k] = *(const LAS bf16x8*)(lds + PG8_SB(b, h) + boff + n * 2048 + k * 1024); } while (0)
#define PG8_MMA(ai, bj, At, Bt) do { __builtin_amdgcn_s_setprio(1); _Pragma("unroll") for (int m = 0; m < 4; ++m) _Pragma("unroll") for (int n = 0; n < 2; ++n) _Pragma("unroll") for (int k = 0; k < 2; ++k) \
        acc[ai][bj][m][n] = __builtin_amdgcn_mfma_f32_16x16x32_bf16(Bt[n][k], At[m][k], acc[ai][bj][m][n], 0, 0, 0); __builtin_amdgcn_s_setprio(0); } while (0)
#define PG8_WAIT_V(n) asm volatile("s_waitcnt vmcnt(" #n ")" ::: "memory")
#define PG8_WAIT_L(n) asm volatile("s_waitcnt lgkmcnt(" #n ")" ::: "memory")
#define PG8_BAR __builtin_amdgcn_s_barrier()
#define PG8_SCHED __builtin_amdgcn_sched_barrier(0)
    Unit cur, nxt; int ui = 0;
    if (!S.next(0, cur)) return;
    if (cur.nt <= 0) cur.nt = nt_all;
    f32x4 acc[2][2][4][2];
#pragma unroll
    for (int a = 0; a < 2; ++a)
#pragma unroll
        for (int b = 0; b < 2; ++b)
#pragma unroll
            for (int m = 0; m < 4; ++m)
#pragma unroll
                for (int n = 0; n < 2; ++n) acc[a][b][m][n] = (f32x4){0.f, 0.f, 0.f, 0.f};
    bf16x8 At[4][2], B0[2][2], B1[2][2];
    const char* cA = (const char*)(g.A + (size_t)cur.pg * g.gsA) + (size_t)cur.pm * tstepA + (size_t)cur.kt0 * kstep; const char* cB = (const char*)(g.Bt + (size_t)cur.pg * g.gsB) + (size_t)cur.pn * tstepB + (size_t)cur.kt0 * kstep;
    PG8_STAGE(PG8_SB(0, 0), cB, voffB); PG8_STAGE(PG8_SB(0, 1), cB + hstepB, voffB); PG8_STAGE(PG8_SA(0, 0), cA, voffA); PG8_STAGE(PG8_SA(0, 1), cA + hstepA, voffA);
    if (wr == 1) PG8_BAR;
    PG8_WAIT_V(2); PG8_BAR;
    PG8_STAGE(PG8_SB(1, 0), cB + kstep, voffB); PG8_STAGE(PG8_SA(1, 0), cA + kstep, voffA); PG8_STAGE(PG8_SB(1, 1), cB + hstepB + kstep, voffB);
    PG8_WAIT_V(6); PG8_BAR;
    for (;;) {
        const bool has_next = S.next(ui + 1, nxt);
        if (has_next && nxt.nt <= 0) nxt.nt = nt_all;
        const int nt = cur.nt;
        const char* nA = has_next ? (const char*)(g.A + (size_t)nxt.pg * g.gsA) + (size_t)nxt.pm * tstepA + (size_t)nxt.kt0 * kstep : cA;
        const char* nB = has_next ? (const char*)(g.Bt + (size_t)nxt.pg * g.gsB) + (size_t)nxt.pn * tstepB + (size_t)nxt.kt0 * kstep : cB;
        for (int t = 0; t < nt; t += 2) {
            const bool last = (t == nt - 2);
            const char* a1 = cA + (size_t)(t + 1) * kstep;
            const char* a2 = last ? nA : cA + (size_t)(t + 2) * kstep; const char* b2 = last ? nB : cB + (size_t)(t + 2) * kstep;
            const char* a3 = a2 + kstep; const char* b3 = b2 + kstep;
            PG8_LDB(B0, 0, 0); PG8_LDB(B1, 0, 1); PG8_SCHED; PG8_LDA(At, 0, 0); PG8_STAGE(PG8_SA(1, 1), a1 + hstepA, voffA);
            PG8_WAIT_V(8); PG8_WAIT_L(0); PG8_BAR; PG8_MMA(0, 0, At, B0); PG8_MMA(0, 1, At, B1); PG8_BAR; PG8_SCHED;
            PG8_LDA(At, 0, 1); PG8_STAGE(PG8_SB(0, 0), b2, voffB); PG8_STAGE(PG8_SB(0, 1), b2 + hstepB, voffB); PG8_STAGE(PG8_SA(0, 0), a2, voffA);
            PG8_WAIT_V(8); PG8_WAIT_L(0); PG8_BAR; PG8_MMA(1, 0, At, B0); PG8_MMA(1, 1, At, B1); PG8_BAR; PG8_SCHED;
            PG8_LDB(B0, 1, 0); PG8_LDB(B1, 1, 1); PG8_SCHED; PG8_LDA(At, 1, 0); PG8_STAGE(PG8_SA(0, 1), a2 + hstepA, voffA);
            PG8_WAIT_V(8); PG8_WAIT_L(0); PG8_BAR; PG8_MMA(0, 0, At, B0); PG8_MMA(0, 1, At, B1); PG8_BAR; PG8_SCHED;
            PG8_LDA(At, 1, 1); PG8_STAGE(PG8_SB(1, 0), b3, voffB); PG8_STAGE(PG8_SB(1, 1), b3 + hstepB, voffB); PG8_STAGE(PG8_SA(1, 0), a3, voffA);
            PG8_WAIT_V(8); PG8_WAIT_L(0); PG8_BAR; PG8_MMA(1, 0, At, B0); PG8_MMA(1, 1, At, B1); PG8_BAR; PG8_SCHED;
        }
        if (wr == 0) PG8_BAR;
        E(acc, cur, wr, wc, fr, fq);
        if (!has_next) break;
#pragma unroll
        for (int a = 0; a < 2; ++a)
#pragma unroll
            for (int b = 0; b < 2; ++b)
#pragma unroll
                for (int m = 0; m < 4; ++m)
#pragma unroll
                    for (int n = 0; n < 2; ++n) acc[a][b][m][n] = (f32x4){0.f, 0.f, 0.f, 0.f};
        cur = nxt; cA = nA; cB = nB; ++ui;
        if (wr == 1) PG8_BAR;
    }
    PG8_WAIT_V(0);
    PG8_BAR;
#undef PG8_SA
#undef PG8_SB
#undef PG8_STAGE
#undef PG8_LDA
#undef PG8_LDB
#undef PG8_MMA
#undef PG8_WAIT_V
#undef PG8_WAIT_L
#undef PG8_BAR
#undef PG8_SCHED
}
}

typedef f32x4 Acc[2][2][4][2];
#define EPI_LOOP _Pragma("unroll") for (int ai = 0; ai < 2; ++ai) _Pragma("unroll") for (int m = 0; m < 4; ++m, ({ if (!(m & 1)) asm volatile("" ::: "memory"); })) _Pragma("unroll") for (int bj = 0; bj < 2; ++bj)

struct EpiQKV {
    const float* bias; const float* rope; bf16_t* Q; bf16_t* Kb; bf16_t* Vb; bf16_t* KS; bf16_t* VS; float* okp; float* ovp; float* oks; float* ovs;
    __device__ __forceinline__ void operator()(Acc& acc, const pg8::Unit& u, int wr, int wc, int fr, int fq) const {
        EPI_LOOP {
            const int row = u.pm * 256 + ai * 128 + wr * 64 + m * 16 + fr, col0 = u.pn * 256 + bj * 128 + wc * 32 + fq * 8;
            const f32x4 v0 = acc[ai][bj][m][0], v1 = acc[ai][bj][m][1];
            const bool smp = row >= MP; const int rs = row - MP;
            const int pos = smp ? 4096 + (rs & 63) : (row & 4095);
            if (col0 < 1152) {
                const int hb = col0 & ~63, i0 = (col0 & 63) >> 1;
                const f32x4 b1 = *(const f32x4*)(bias + hb + i0), b2 = *(const f32x4*)(bias + hb + 32 + i0);
                const f32x4 cs0 = *(const f32x4*)(rope + ((size_t)pos * 32 + i0) * 2), cs1 = *(const f32x4*)(rope + ((size_t)pos * 32 + i0) * 2 + 4);
                const f32x4 x1 = (f32x4){v0[0], v0[2], v1[0], v1[2]} + b1, x2 = (f32x4){v0[1], v0[3], v1[1], v1[3]} + b2;
                const f32x4 cc = (f32x4){cs0[0], cs0[2], cs1[0], cs1[2]}, ss = (f32x4){cs0[1], cs0[3], cs1[1], cs1[3]};
                f32x4 o1 = x1 * cc - x2 * ss, o2 = x2 * cc + x1 * ss;
                if (col0 < 1024) {
                    o1 = o1 * 0.18033688011112042f; o2 = o2 * 0.18033688011112042f;
                    u32x4 w; w.x = cvt_pk_bf16(o1[0], o2[0]); w.y = cvt_pk_bf16(o1[1], o2[1]); w.z = cvt_pk_bf16(o1[2], o2[2]); w.w = cvt_pk_bf16(o1[3], o2[3]);
                    *(u32x4*)(Q + (size_t)row * D + col0) = w;
                } else {
                    const int kc = col0 - 1024;
                    u32x4 w; w.x = cvt_pk_bf16(o1[0], o2[0]); w.y = cvt_pk_bf16(o1[1], o2[1]); w.z = cvt_pk_bf16(o1[2], o2[2]); w.w = cvt_pk_bf16(o1[3], o2[3]);
                    const int oc = (kc & 64) + i0;
                    if (!smp) {
                        *(u32x4*)(Kb + (size_t)row * 128 + kc) = w;
                        const int s = row & 4095;
                        if (s >= 3968) { float* o = okp + ((size_t)((row >> 12) * 128 + (s - 3968)) * 128) + oc; *(f32x4*)o = o1; *(f32x4*)(o + 32) = o2; }
                    } else {
                        const int b = rs >> 6, t = rs & 63;
                        *(u32x4*)(KS + (size_t)(b * 192 + 128 + t) * 128 + kc) = w;
                        float* o = oks + ((size_t)(b * 128 + 64 + t) * 128) + oc; *(f32x4*)o = o1; *(f32x4*)(o + 32) = o2;
                    }
                }
            } else {
                const int vc = col0 - 1152;
                const f32x4 a0 = v0 + *(const f32x4*)(bias + col0), a1 = v1 + *(const f32x4*)(bias + col0 + 4);
                u32x4 w; w.x = cvt_pk_bf16(a0[0], a0[1]); w.y = cvt_pk_bf16(a0[2], a0[3]); w.z = cvt_pk_bf16(a1[0], a1[1]); w.w = cvt_pk_bf16(a1[2], a1[3]);
                if (!smp) {
                    *(u32x4*)(Vb + (size_t)row * 128 + vc) = w;
                    const int s = row & 4095;
                    if (s >= 3968) { float* o = ovp + ((size_t)((row >> 12) * 128 + (s - 3968)) * 128) + vc; *(f32x4*)o = a0; *(f32x4*)(o + 4) = a1; }
                } else {
                    const int b = rs >> 6, t = rs & 63;
                    *(u32x4*)(VS + (size_t)(b * 192 + 128 + t) * 128 + vc) = w;
                    float* o = ovs + ((size_t)(b * 128 + 64 + t) * 128) + vc; *(f32x4*)o = a0; *(f32x4*)(o + 4) = a1;
                }
            }
        }
    }
};
struct EpiResid {
    const float* xp; const float* xs; const float* bias; float* Z;
    __device__ __forceinline__ void operator()(Acc& acc, const pg8::Unit& u, int wr, int wc, int fr, int fq) const {
        EPI_LOOP {
            const int row = u.pm * 256 + ai * 128 + wr * 64 + m * 16 + fr, col0 = u.pn * 256 + bj * 128 + wc * 32 + fq * 8;
            const float* xr = (row < MP ? xp + (size_t)row * D : xs + (size_t)(row - MP) * D) + col0;
            f32x4 a0 = acc[ai][bj][m][0], a1 = acc[ai][bj][m][1];
            if (bias) { a0 += *(const f32x4*)(bias + col0); a1 += *(const f32x4*)(bias + col0 + 4); }
            const f32x4 x0 = *(const f32x4*)xr, x1 = *(const f32x4*)(xr + 4);
            float* z = Z + (size_t)row * D + col0;
            *(f32x4*)z = x0 * ALPHA + a0; *(f32x4*)(z + 4) = x1 * ALPHA + a1;
        }
    }
};
__device__ __forceinline__ float silu_mul(float g, float u) { return g * u * __builtin_amdgcn_rcpf(1.f + __expf(-g)); }
__device__ __forceinline__ unsigned silu_mul2_pk(float g0, float u0, float g1, float u1) {
    const float e0 = __builtin_amdgcn_exp2f(fminf(-1.4426950408889634f * g0, 43.f)), e1 = __builtin_amdgcn_exp2f(fminf(-1.4426950408889634f * g1, 43.f));
    const float d0 = 1.f + e0, d1 = 1.f + e1, r = __builtin_amdgcn_rcpf(d0 * d1);
    return cvt_pk_bf16((g0 * u0) * (r * d1), (g1 * u1) * (r * d0));
}
struct EpiSwiGLU {
    bf16_t* H; unsigned* pub;
    __device__ __forceinline__ void operator()(Acc& acc, const pg8::Unit& u, int wr, int wc, int fr, int fq) const {
        body(acc, u, wr, wc, fr, fq);
        if (pub && u.pm >= 128) {
            asm volatile("s_waitcnt vmcnt(0)" ::: "memory"); __builtin_amdgcn_s_barrier(); asm volatile("" ::: "memory");
            if (wr == 0 && wc == 0) { __builtin_amdgcn_fence(__ATOMIC_RELEASE, "agent"); asm volatile("s_waitcnt vmcnt(0)" ::: "memory");
                                      if (fr == 0 && fq == 0) __hip_atomic_fetch_add(pub, 1u, __ATOMIC_RELAXED, __HIP_MEMORY_SCOPE_AGENT); }
        }
    }
    __device__ __forceinline__ void body(Acc& acc, const pg8::Unit& u, int wr, int wc, int fr, int fq) const {
        const int hcol = u.pn * 128 + wc * 32 + fq * 8;
#pragma unroll
        for (int ai = 0; ai < 2; ++ai)
#pragma unroll
            for (int m = 0; m < 4; ++m) {
                const int row = u.pm * 256 + ai * 128 + wr * 64 + m * 16 + fr;
                const f32x4 a0 = acc[ai][0][m][0], a1 = acc[ai][0][m][1], b0 = acc[ai][1][m][0], b1 = acc[ai][1][m][1];
                u32x4 w; w.x = silu_mul2_pk(a0[0], a0[1], a0[2], a0[3]); w.y = silu_mul2_pk(a1[0], a1[1], a1[2], a1[3]);
                w.z = silu_mul2_pk(b0[0], b0[1], b0[2], b0[3]); w.w = silu_mul2_pk(b1[0], b1[1], b1[2], b1[3]);
                *(u32x4*)(H + (size_t)row * DFF + hcol) = w;
            }
    }
};
struct EpiSsmIn {
    const float* bias; bf16_t* U;
    __device__ __forceinline__ void operator()(Acc& acc, const pg8::Unit& u, int wr, int wc, int fr, int fq) const {
        f32x4 bs[2][2];
#pragma unroll
        for (int bj = 0; bj < 2; ++bj) { const int cb = u.pn * 256 + bj * 128 + wc * 32 + fq * 8; bs[bj][0] = *(const f32x4*)(bias + cb); bs[bj][1] = *(const f32x4*)(bias + cb + 4); }
        EPI_LOOP {
            const int row = u.pm * 256 + ai * 128 + wr * 64 + m * 16 + fr, col0 = u.pn * 256 + bj * 128 + wc * 32 + fq * 8;
            const f32x4 a0 = acc[ai][bj][m][0] + bs[bj][0], a1 = acc[ai][bj][m][1] + bs[bj][1];
            u32x4 w; w.x = cvt_pk_bf16(a0[0], a0[1]); w.y = cvt_pk_bf16(a0[2], a0[3]); w.z = cvt_pk_bf16(a1[0], a1[1]); w.w = cvt_pk_bf16(a1[2], a1[3]);
            const int g = col0 >> 4, bc = row >> 6, j = row & 63;
            *(u32x4*)(U + ((size_t)(g * NBC + bc) * KT) + 128 + j * 16 + (col0 & 15)) = w;
        }
    }
};
struct EpiDS {
    float* DS;
    __device__ __forceinline__ void operator()(Acc& acc, const pg8::Unit& u, int wr, int wc, int fr, int fq) const {
#pragma unroll
        for (int ai = 0; ai < 2; ++ai)
#pragma unroll
            for (int m = 0; m < 4; ++m) {
                const int bc = u.pm * 256 + ai * 128 + wr * 64 + m * 16 + fr, col0 = wc * 32 + fq * 8;
                if (bc < NBC) { float* o = DS + ((size_t)(u.pg * NBC + bc) * 128) + col0; *(f32x4*)o = acc[ai][0][m][0]; *(f32x4*)(o + 4) = acc[ai][0][m][1]; }
            }
    }
};
__device__ __forceinline__ float gelu_tanh(float y) { const float t = 0.7978845608028654f * (y + 0.044715f * y * y * y); return y * __builtin_amdgcn_rcpf(1.f + __expf(-2.f * t)); }
struct EpiToep {
    const bf16_t* U; const float* dvec; bf16_t* ZG;
    __device__ __forceinline__ void operator()(Acc& acc, const pg8::Unit& u, int wr, int wc, int fr, int fq) const {
        const int bcb = u.pm * 256 + wr * 64 + fr, nb = u.pn * 256 + wc * 32 + fq * 8, c0 = nb & 15, ch = u.pg * 16 + c0;
        const f32x4 d0 = *(const f32x4*)(dvec + ch), d1 = *(const f32x4*)(dvec + ch + 4);
        u32x4 uw[2][4][2];
#pragma unroll
        for (int ai = 0; ai < 2; ++ai)
#pragma unroll
            for (int m = 0; m < 4; ++m)
#pragma unroll
                for (int bj = 0; bj < 2; ++bj) { const int bc = bcb + ai * 128 + m * 16; uw[ai][m][bj] = (u32x4){0u, 0u, 0u, 0u};
                    if (bc < NBC) uw[ai][m][bj] = *(const u32x4*)(U + ((size_t)(u.pg * NBC + bc) * KT) + 128 + nb + bj * 128); }
        EPI_LOOP {
            const int bc = bcb + ai * 128 + m * 16, n0 = nb + bj * 128;
            if (bc < NBC) {
                const int t = n0 >> 4;
                const u32x4 w_ = uw[ai][m][bj];
                const f32x4 v0 = acc[ai][bj][m][0], v1 = acc[ai][bj][m][1];
                const float y0 = v0[0] + d0[0] * bflo(w_.x), y1 = v0[1] + d0[1] * bfhi(w_.x), y2 = v0[2] + d0[2] * bflo(w_.y), y3 = v0[3] + d0[3] * bfhi(w_.y);
                const float y4 = v1[0] + d1[0] * bflo(w_.z), y5 = v1[1] + d1[1] * bfhi(w_.z), y6 = v1[2] + d1[2] * bflo(w_.w), y7 = v1[3] + d1[3] * bfhi(w_.w);
                u32x4 w; w.x = cvt_pk_bf16(gelu_tanh(y0), gelu_tanh(y1)); w.y = cvt_pk_bf16(gelu_tanh(y2), gelu_tanh(y3));
                w.z = cvt_pk_bf16(gelu_tanh(y4), gelu_tanh(y5)); w.w = cvt_pk_bf16(gelu_tanh(y6), gelu_tanh(y7));
                *(u32x4*)(ZG + (size_t)(bc * 64 + t) * D + ch) = w;
            }
        }
    }
};
struct EpiGLU {
    const float* bias; const float* X; float* Z;
    __device__ __forceinline__ void operator()(Acc& acc, const pg8::Unit& u, int wr, int wc, int fr, int fq) const {
        EPI_LOOP {
            const int row = u.pm * 256 + ai * 128 + wr * 64 + m * 16 + fr, col0 = u.pn * 256 + bj * 128 + wc * 32 + fq * 8, oc = col0 >> 1;
            const f32x4 v0 = acc[ai][bj][m][0], v1 = acc[ai][bj][m][1];
            const f32x4 bv = *(const f32x4*)(bias + oc), bg = *(const f32x4*)(bias + D + oc);
            const f32x4 x = *(const f32x4*)(X + (size_t)row * D + oc);
            f32x4 o;
            o[0] = (v0[0] + bv[0]) * __builtin_amdgcn_rcpf(1.f + __expf(-(v0[1] + bg[0])));
            o[1] = (v0[2] + bv[1]) * __builtin_amdgcn_rcpf(1.f + __expf(-(v0[3] + bg[1])));
            o[2] = (v1[0] + bv[2]) * __builtin_amdgcn_rcpf(1.f + __expf(-(v1[1] + bg[2])));
            o[3] = (v1[2] + bv[3]) * __builtin_amdgcn_rcpf(1.f + __expf(-(v1[3] + bg[3])));
            *(f32x4*)(Z + (size_t)row * D + oc) = x * ALPHA + o;
        }
    }
};


constexpr size_t WS_XBUF = 506 * MiB, WS_CNT = 509 * MiB;
constexpr size_t WS_END2 = 510 * MiB;
struct LnX { unsigned long long* xbuf; unsigned tag; const float* gain; const float* beta; LAS unsigned char* lx; };
template <int NV>
__device__ __forceinline__ void panel_ln_stats(const Acc& v, int pm, int pn, int ntn, const LnX& L, int wr, int wc, int fr, int fq) {
    LAS f32x2* P = (LAS f32x2*)L.lx;
    LAS f32x2* S = (LAS f32x2*)(L.lx + 8192);
    const int wid = wr * 4 + wc, lane = fq * 16 + fr;
    constexpr float NW = 32.f * NV;
#pragma unroll
    for (int ai = 0; ai < 2; ++ai)
#pragma unroll
        for (int m = 0; m < 4; ++m) {
            float s = 0.f;
#pragma unroll
            for (int bj = 0; bj < 2; ++bj)
#pragma unroll
                for (int n = 0; n < NV; ++n) { const f32x4 x = v[ai][bj][m][n]; s += (x[0] + x[1]) + (x[2] + x[3]); }
            s += __shfl_xor(s, 16); s += __shfl_xor(s, 32);
            const float mw = s * (1.0f / NW); float q = 0.f;
#pragma unroll
            for (int bj = 0; bj < 2; ++bj)
#pragma unroll
                for (int n = 0; n < NV; ++n) { const f32x4 d = v[ai][bj][m][n] - mw; q += (d[0] * d[0] + d[1] * d[1]) + (d[2] * d[2] + d[3] * d[3]); }
            q += __shfl_xor(q, 16); q += __shfl_xor(q, 32);
            if (fq == 0) P[(ai * 128 + wr * 64 + m * 16 + fr) * 4 + wc] = (f32x2){mw, q};
        }
    asm volatile("s_waitcnt lgkmcnt(0)" ::: "memory"); __builtin_amdgcn_s_barrier(); asm volatile("" ::: "memory");
    const int row = wid * 32 + (lane & 31);
    unsigned long long* slots = L.xbuf + ((size_t)(pm * 256 + row) * 8);
    const unsigned tag = L.tag;
    if (lane < 32) {
        const f32x2 a = P[row * 4 + 0], b = P[row * 4 + 1], c = P[row * 4 + 2], d = P[row * 4 + 3];
        const float mt = (a.x + b.x + c.x + d.x) * 0.25f;
        const float da = a.x - mt, db = b.x - mt, dc = c.x - mt, dd = d.x - mt;
        const float m2 = (a.y + b.y) + (c.y + d.y) + NW * ((da * da + db * db) + (dc * dc + dd * dd));
        const unsigned m2b = (__float_as_uint(m2) & ~15u) | tag;
        __hip_atomic_store(slots + pn, ((unsigned long long)m2b << 32) | __float_as_uint(mt), __ATOMIC_RELAXED, __HIP_MEMORY_SCOPE_AGENT);
    }
    {
        float mt[8], m2[8]; unsigned sp = 0;
        for (;;) {
            int bad = 0;
            if (lane < 32) {
#pragma unroll
                for (int t = 0; t < 8; ++t) {
                    if (t < ntn) { const unsigned long long w = __hip_atomic_load(slots + t, __ATOMIC_RELAXED, __HIP_MEMORY_SCOPE_AGENT); const unsigned hi = (unsigned)(w >> 32);
                                   bad |= ((hi & 15u) != tag) ? 1 : 0; mt[t] = __uint_as_float((unsigned)w); m2[t] = __uint_as_float(hi & ~15u); }
                    else { mt[t] = 0.f; m2[t] = 0.f; }
                }
            }
            if (!__any(bad) || ++sp > (1u << 18)) break;
            __builtin_amdgcn_s_sleep(1);
        }
        if (lane < 32) {
            float ms = 0.f;
#pragma unroll
            for (int t = 0; t < 8; ++t) ms += mt[t];
            const float mean = ms / (float)ntn; float q = 0.f;
#pragma unroll
            for (int t = 0; t < 8; ++t) if (t < ntn) { const float dm = mt[t] - mean; q += m2[t] + (4.f * NW) * dm * dm; }
            S[row] = (f32x2){mean, 1.0f / sqrtf(q / (4.f * NW * (float)ntn) + LN_EPS)};
        }
    }
    asm volatile("s_waitcnt lgkmcnt(0)" ::: "memory"); __builtin_amdgcn_s_barrier(); asm volatile("" ::: "memory");
}
#define EPI_LOOP_NF _Pragma("unroll") for (int ai = 0; ai < 2; ++ai) _Pragma("unroll") for (int m = 0; m < 4; ++m) _Pragma("unroll") for (int bj = 0; bj < 2; ++bj)
template <bool FIN> struct EpiResidLN {
    const float* bias; float* Y; bf16_t* XN; LnX L;
    __device__ __forceinline__ void operator()(Acc& acc, const pg8::Unit& u, int wr, int wc, int fr, int fq) const {
        const int rowb = u.pm * 256 + wr * 64 + fr, colb = u.pn * 256 + wc * 32 + fq * 8;
        u32x4 xw[2][4][2];
        EPI_LOOP_NF xw[ai][m][bj] = *(const u32x4*)(XN + (size_t)(rowb + ai * 128 + m * 16) * D + colb + bj * 128);
        f32x4 bs[2][2];
#pragma unroll
        for (int bj = 0; bj < 2; ++bj) { bs[bj][0] = bias ? *(const f32x4*)(bias + colb + bj * 128) : (f32x4){0.f, 0.f, 0.f, 0.f}; bs[bj][1] = bias ? *(const f32x4*)(bias + colb + bj * 128 + 4) : (f32x4){0.f, 0.f, 0.f, 0.f}; }
        EPI_LOOP_NF {
            const u32x4 w = xw[ai][m][bj];
            acc[ai][bj][m][0] = (f32x4){bflo(w.x), bfhi(w.x), bflo(w.y), bfhi(w.y)} * ALPHA + (acc[ai][bj][m][0] + bs[bj][0]);
            acc[ai][bj][m][1] = (f32x4){bflo(w.z), bfhi(w.z), bflo(w.w), bfhi(w.w)} * ALPHA + (acc[ai][bj][m][1] + bs[bj][1]);
            asm volatile("" : "+v"(acc[ai][bj][m][0]), "+v"(acc[ai][bj][m][1]));
        }
        asm volatile("" ::: "memory");
        f32x4 gb[2][4];
#pragma unroll
        for (int bj = 0; bj < 2; ++bj) { gb[bj][0] = *(const f32x4*)(L.gain + colb + bj * 128); gb[bj][1] = *(const f32x4*)(L.gain + colb + bj * 128 + 4);
                                         gb[bj][2] = *(const f32x4*)(L.beta + colb + bj * 128); gb[bj][3] = *(const f32x4*)(L.beta + colb + bj * 128 + 4); }
        panel_ln_stats<2>(acc, u.pm, u.pn, 4, L, wr, wc, fr, fq);
        const LAS f32x2* S = (const LAS f32x2*)(L.lx + 8192);
        EPI_LOOP {
            const int r = ai * 128 + wr * 64 + m * 16 + fr, row = u.pm * 256 + r, col0 = colb + bj * 128;
            const f32x2 sr = S[r];
            const f32x4 y0 = (acc[ai][bj][m][0] - sr.x) * sr.y * gb[bj][0] + gb[bj][2], y1 = (acc[ai][bj][m][1] - sr.x) * sr.y * gb[bj][1] + gb[bj][3];
            if (FIN) { float* xo = Y + (size_t)row * D + col0; *(f32x4*)xo = y0; *(f32x4*)(xo + 4) = y1; }
            else { u32x4 w; w.x = cvt_pk_bf16(y0[0], y0[1]); w.y = cvt_pk_bf16(y0[2], y0[3]); w.z = cvt_pk_bf16(y1[0], y1[1]); w.w = cvt_pk_bf16(y1[2], y1[3]);
                   *(u32x4*)(XN + (size_t)row * D + col0) = w; }
        }
    }
};
struct EpiGLULN {
    const float* bias; bf16_t* XN; LnX L;
    __device__ __forceinline__ void operator()(Acc& acc, const pg8::Unit& u, int wr, int wc, int fr, int fq) const {
        const int rowb = u.pm * 256 + wr * 64 + fr, ocb = u.pn * 128 + wc * 32 + fq * 8;
        u32x4 xw[2][4];
#pragma unroll
        for (int ai = 0; ai < 2; ++ai)
#pragma unroll
            for (int m = 0; m < 4; ++m) xw[ai][m] = *(const u32x4*)(XN + (size_t)(rowb + ai * 128 + m * 16) * D + ocb);
        f32x4 bvg[2][2];
#pragma unroll
        for (int bj = 0; bj < 2; ++bj) { bvg[bj][0] = *(const f32x4*)(bias + ocb + 4 * bj); bvg[bj][1] = *(const f32x4*)(bias + D + ocb + 4 * bj); }
        EPI_LOOP_NF {
            const f32x4 v0 = acc[ai][bj][m][0], v1 = acc[ai][bj][m][1];
            const f32x4 bv = bvg[bj][0], bg = bvg[bj][1];
            const unsigned wlo = bj ? xw[ai][m].z : xw[ai][m].x, whi = bj ? xw[ai][m].w : xw[ai][m].y;
            const f32x4 x = (f32x4){bflo(wlo), bfhi(wlo), bflo(whi), bfhi(whi)};
            f32x4 o;
            o[0] = (v0[0] + bv[0]) * __builtin_amdgcn_rcpf(1.f + __expf(-(v0[1] + bg[0])));
            o[1] = (v0[2] + bv[1]) * __builtin_amdgcn_rcpf(1.f + __expf(-(v0[3] + bg[1])));
            o[2] = (v1[0] + bv[2]) * __builtin_amdgcn_rcpf(1.f + __expf(-(v1[1] + bg[2])));
            o[3] = (v1[2] + bv[3]) * __builtin_amdgcn_rcpf(1.f + __expf(-(v1[3] + bg[3])));
            acc[ai][bj][m][0] = x * ALPHA + o;
            asm volatile("" : "+v"(acc[ai][bj][m][0]));
        }
        asm volatile("" ::: "memory");
        f32x4 gb[2][2];
#pragma unroll
        for (int bj = 0; bj < 2; ++bj) { gb[bj][0] = *(const f32x4*)(L.gain + ocb + 4 * bj); gb[bj][1] = *(const f32x4*)(L.beta + ocb + 4 * bj); }
        panel_ln_stats<1>(acc, u.pm, u.pn, 8, L, wr, wc, fr, fq);
        const LAS f32x2* S = (const LAS f32x2*)(L.lx + 8192);
#pragma unroll
        for (int ai = 0; ai < 2; ++ai)
#pragma unroll
            for (int m = 0; m < 4; ++m) {
                const int r = ai * 128 + wr * 64 + m * 16 + fr, row = u.pm * 256 + r;
                const f32x2 sr = S[r];
                const f32x4 y0 = (acc[ai][0][m][0] - sr.x) * sr.y * gb[0][0] + gb[0][1], y1 = (acc[ai][1][m][0] - sr.x) * sr.y * gb[1][0] + gb[1][1];
                u32x4 w; w.x = cvt_pk_bf16(y0[0], y0[1]); w.y = cvt_pk_bf16(y0[2], y0[3]); w.z = cvt_pk_bf16(y1[0], y1[1]); w.w = cvt_pk_bf16(y1[2], y1[3]);
                *(u32x4*)(XN + (size_t)row * D + ocb) = w;
            }
    }
};

__device__ __forceinline__ float wave_sum(float v) {
#pragma unroll
    for (int o = 1; o < 64; o <<= 1) v += __shfl_xor(v, o);
    return v;
}
__device__ __forceinline__ int perm_col(int n, int mode, int N) {
    if (mode == 1) { if (n >= 1152) return n; const int h = n >> 6, i = n & 63; return (h << 6) + (i < 32 ? 2 * i : 2 * (i - 32) + 1); }
    if (mode == 2) { const int half = N >> 1; return n < half ? 2 * n : 2 * (n - half) + 1; }
    if (mode == 3) {
        const int half = N >> 1, which = n < half ? 0 : 1, h = n - which * half;
        const int pn = h >> 7, r = h & 127, wc = r >> 5, fq = (r >> 3) & 3, bj = (r >> 2) & 1, jj = r & 3;
        return 256 * pn + 128 * bj + 32 * wc + 8 * fq + 2 * jj + which;
    }
    return n;
}
__device__ __forceinline__ void transpose_item(const float* W, int K, int N, bf16_t* WT, int mode, LAS float* scr, int item, int lane) {
    const int nblk = N / 32, kb = item / nblk, nb = item % nblk, k0 = 64 * kb, n0 = 32 * nb;
    float tmp[32];
#pragma unroll
    for (int i = 0; i < 32; ++i) tmp[i] = __builtin_nontemporal_load(W + (size_t)(k0 + 2 * i + (lane >> 5)) * N + n0 + (lane & 31));
#pragma unroll
    for (int i = 0; i < 32; ++i) scr[(2 * i + (lane >> 5)) * 33 + (lane & 31)] = tmp[i];
    asm volatile("s_waitcnt lgkmcnt(0)" ::: "memory");
    const int c = lane & 7;
#pragma unroll
    for (int j = 0; j < 4; ++j) { const int n = (lane >> 3) + 8 * j; const LAS float* s = scr + (8 * c) * 33 + n;
        u32x4 o; o.x = cvt_pk_bf16(s[0 * 33], s[1 * 33]); o.y = cvt_pk_bf16(s[2 * 33], s[3 * 33]); o.z = cvt_pk_bf16(s[4 * 33], s[5 * 33]); o.w = cvt_pk_bf16(s[6 * 33], s[7 * 33]);
        *(u32x4*)(WT + (size_t)perm_col(n0 + n, mode, N) * K + k0 + 8 * c) = o; }
    asm volatile("s_waitcnt lgkmcnt(0)" ::: "memory");
}
struct TItem { const float* W; bf16_t* WT; int K, N, mode, item; };
__device__ __forceinline__ void transpose_load(const TItem& t, int lane, float (&tmp)[32]) {
    const int nblk = t.N / 32, kb = t.item / nblk, nb = t.item % nblk, k0 = 64 * kb, n0 = 32 * nb;
#pragma unroll
    for (int i = 0; i < 32; ++i) tmp[i] = __builtin_nontemporal_load(t.W + (size_t)(k0 + 2 * i + (lane >> 5)) * t.N + n0 + (lane & 31));
}
__device__ __forceinline__ void transpose_finish(const TItem& t, LAS float* scr, int lane, const float (&tmp)[32]) {
    const int nblk = t.N / 32, kb = t.item / nblk, nb = t.item % nblk, k0 = 64 * kb, n0 = 32 * nb;
#pragma unroll
    for (int i = 0; i < 32; ++i) scr[(2 * i + (lane >> 5)) * 33 + (lane & 31)] = tmp[i];
    asm volatile("s_waitcnt lgkmcnt(0)" ::: "memory");
    const int c = lane & 7;
#pragma unroll
    for (int j = 0; j < 4; ++j) { const int n = (lane >> 3) + 8 * j; const LAS float* sp = scr + (8 * c) * 33 + n;
        u32x4 o; o.x = cvt_pk_bf16(sp[0 * 33], sp[1 * 33]); o.y = cvt_pk_bf16(sp[2 * 33], sp[3 * 33]); o.z = cvt_pk_bf16(sp[4 * 33], sp[5 * 33]); o.w = cvt_pk_bf16(sp[6 * 33], sp[7 * 33]);
        *(u32x4*)(t.WT + (size_t)perm_col(n0 + n, t.mode, t.N) * t.K + k0 + 8 * c) = o; }
    asm volatile("s_waitcnt lgkmcnt(0)" ::: "memory");
}
__device__ __forceinline__ void cis_red(double ang, float& c, float& s) {
    const double k = rint(ang * 0.15915494309189535); const float r = (float)(ang - k * 6.283185307179586);
    c = cosf(r); s = sinf(r);
}

struct Args { const float* in[N_IN]; float* out; unsigned char* ws; int ph_lo, ph_hi; };

__device__ __forceinline__ void prologue(const Args& a, LAS unsigned char* lds, int G, int bid, int wave_s) {
    int tid = wave_s * 64 + my_lane(); asm volatile("" : "+v"(tid));
    const int lane = tid & 63, wave = tid >> 6;
    const int gw = bid * 8 + wave, NGW = G * 8;
    unsigned char* ws = a.ws;
    LAS float* scr = (LAS float*)(lds + wave * 16384);
    constexpr int C_QKV = 16 * 40, C_WO = 16 * 32, C_GLU = 16 * 64, C_UP = 16 * 176, C_DN = 44 * 32;
    constexpr int NITEMS = 2 * C_QKV + 4 * C_WO + 2 * C_GLU + 4 * C_UP + 4 * C_DN;
#define TITEM_DECODE(T_, idx_) do { int r = (idx_); \
        if (r < 2 * C_QKV) { const int l = r / C_QKV; T_ = TItem{a.in[I_WQKV] + (size_t)l * D * NQKV, (bf16_t*)(ws + WS_WQKV) + (size_t)l * NQKV * D, D, NQKV, 1, r % C_QKV}; break; } r -= 2 * C_QKV; \
        if (r < 2 * C_WO) { const int l = r / C_WO; T_ = TItem{a.in[I_WO] + (size_t)l * D * D, (bf16_t*)(ws + WS_WO) + (size_t)l * D * D, D, D, 0, r % C_WO}; break; } r -= 2 * C_WO; \
        if (r < 2 * C_WO) { const int l = r / C_WO; T_ = TItem{a.in[I_WIN] + (size_t)l * D * D, (bf16_t*)(ws + WS_WIN) + (size_t)l * D * D, D, D, 0, r % C_WO}; break; } r -= 2 * C_WO; \
        if (r < 2 * C_GLU) { const int l = r / C_GLU; T_ = TItem{a.in[I_WGLU] + (size_t)l * D * 2 * D, (bf16_t*)(ws + WS_WGLU) + (size_t)l * 2 * D * D, D, 2 * D, 3, r % C_GLU}; break; } r -= 2 * C_GLU; \
        if (r < 4 * C_UP) { const int l = r / C_UP; T_ = TItem{a.in[I_WUP] + (size_t)l * D * NUP, (bf16_t*)(ws + WS_WUP) + (size_t)l * NUP * D, D, NUP, 3, r % C_UP}; break; } r -= 4 * C_UP; \
        { const int l = r / C_DN; T_ = TItem{a.in[I_WDN] + (size_t)l * DFF * D, (bf16_t*)(ws + WS_WDN) + (size_t)l * D * DFF, DFF, D, 0, r % C_DN}; } } while (0)
    for (int it = gw; it < NITEMS; it += 2 * NGW) {
        const bool has2 = it + NGW < NITEMS;
        TItem ta, tb; TITEM_DECODE(ta, it); TITEM_DECODE(tb, has2 ? it + NGW : it);
        float tma[32], tmb[32];
        transpose_load(ta, lane, tma);
        if (has2) transpose_load(tb, lane, tmb);
        transpose_finish(ta, scr, lane, tma);
        if (has2) transpose_finish(tb, scr, lane, tmb);
    }
#undef TITEM_DECODE
    bf16_t* XN = (bf16_t*)(ws + WS_XN);
    for (int row0 = gw; row0 < MT; row0 += 4 * NGW) {
        f32x4 v[4][4];
#pragma unroll
        for (int h = 0; h < 4; ++h) {
            const int row = row0 + h * NGW; const int rr = row < MT ? row : row0;
            const float* xr = rr < MP ? a.in[I_XP] + (size_t)rr * D : a.in[I_XS] + (size_t)(rr - MP) * D;
#pragma unroll
            for (int j = 0; j < 4; ++j) v[h][j] = __builtin_nontemporal_load((const f32x4*)xr + lane + 64 * j);
        }
#pragma unroll
        for (int h = 0; h < 4; ++h) {
            const int row = row0 + h * NGW;
            if (row < MT) {
#pragma unroll
                for (int j = 0; j < 4; ++j) { u32x2 w; w.x = cvt_pk_bf16(v[h][j][0], v[h][j][1]); w.y = cvt_pk_bf16(v[h][j][2], v[h][j][3]); *((u32x2*)(XN + (size_t)row * D) + lane + 64 * j) = w; }
            }
        }
    }
    const int gt = bid * 512 + tid, NGT = G * 512;
    for (int e = gt; e < 64; e += NGT) __hip_atomic_store((unsigned*)(ws + WS_CNT) + e, 0u, __ATOMIC_RELAXED, __HIP_MEMORY_SCOPE_AGENT);
    for (int e = gt; e < MT * 8; e += NGT) __hip_atomic_store((unsigned long long*)(ws + WS_XBUF) + e, 0ull, __ATOMIC_RELAXED, __HIP_MEMORY_SCOPE_AGENT);
    float* rope = (float*)(ws + WS_ROPE);
    for (int e = gt; e < 4160 * 32; e += NGT) { const int pos = e >> 5, i = e & 31; const double inv = exp(-(double)i * (9.210340371976184 / 32.0)); float c, s; cis_red((double)pos * inv, c, s); rope[2 * e] = c; rope[2 * e + 1] = s; }
    float* lamP = (float*)(ws + WS_LAMP); float* Bb = (float*)(ws + WS_BB);
    for (int e = gt; e < 2 * 64 * 64 * 65; e += NGT) {
        const int tau = e % 65, gp = e / 65, lg = gp >> 6;
        const double dt = exp((double)a.in[I_LOGDT][lg]); const double ar = a.in[I_ARE][gp], ai = a.in[I_AIM][gp];
        const float mag = (float)exp(dt * ar * tau); float c, s; cis_red(dt * ai * tau, c, s);
        lamP[2 * (size_t)e] = mag * c; lamP[2 * (size_t)e + 1] = mag * s;
    }
    for (int e = gt; e < 2 * 64 * 64 * 16; e += NGT) {
        const int gp = e >> 4, lg = gp >> 6;
        const double dt = exp((double)a.in[I_LOGDT][lg]); const double ar = a.in[I_ARE][gp], ai = a.in[I_AIM][gp];
        const double mag = exp(dt * ar); float c, s; cis_red(dt * ai, c, s);
        const double nr = mag * c - 1.0, ni = mag * s, den = ar * ar + ai * ai;
        const double fr_ = (nr * ar + ni * ai) / den, fi_ = (ni * ar - nr * ai) / den;
        const double br = a.in[I_BRE][e], bi = a.in[I_BIM][e];
        Bb[2 * (size_t)e] = (float)(fr_ * br - fi_ * bi); Bb[2 * (size_t)e + 1] = (float)(fr_ * bi + fi_ * br);
    }
    for (int e = gt; e < 2 * 8 * 128 * 128; e += NGT) {
        const int c = e & 127, r = (e >> 7) & 127, lb = e >> 14;
        const float kv = a.in[I_CK][e], vv = a.in[I_CV][e];
        const int i = c & 63, kc = (c & 64) + (i < 32 ? 2 * i : 2 * (i - 32) + 1);
        ((bf16_t*)(ws + WS_KS))[((size_t)lb * 192 + r) * 128 + kc] = (bf16_t)(cvt_pk_bf16(kv, 0.f) & 0xffffu);
        ((bf16_t*)(ws + WS_VS))[((size_t)lb * 192 + r) * 128 + c] = (bf16_t)(cvt_pk_bf16(vv, 0.f) & 0xffffu);
        if (r >= 64) { a.out[O_KSM + ((size_t)lb * 128 + (r - 64)) * 128 + c] = kv; a.out[O_VSM + ((size_t)lb * 128 + (r - 64)) * 128 + c] = vv; }
    }
}

__device__ __forceinline__ void ln_phase(float* X, bf16_t* XN, const float* gain, const float* bias, int G, int bid, int wave_s) {
    int tid = wave_s * 64 + my_lane(); asm volatile("" : "+v"(tid));
    const int lane = tid & 63, wave = tid >> 6, gw = bid * 8 + wave, NGW = G * 8;
    f32x4 gg[4], bb[4];
#pragma unroll
    for (int j = 0; j < 4; ++j) { gg[j] = *((const f32x4*)gain + lane + 64 * j); bb[j] = *((const f32x4*)bias + lane + 64 * j); }
    for (int row = gw; row < MT; row += NGW) {
        f32x4* xr = (f32x4*)(X + (size_t)row * D) + lane;
        f32x4 v[4]; float s = 0.f;
#pragma unroll
        for (int j = 0; j < 4; ++j) { v[j] = xr[64 * j]; s += (v[j][0] + v[j][1]) + (v[j][2] + v[j][3]); }
        const float mean = wave_sum(s) * (1.f / D); float s2 = 0.f;
#pragma unroll
        for (int j = 0; j < 4; ++j) { v[j] = v[j] - mean; s2 += (v[j][0] * v[j][0] + v[j][1] * v[j][1]) + (v[j][2] * v[j][2] + v[j][3] * v[j][3]); }
        const float rstd = 1.f / sqrtf(wave_sum(s2) * (1.f / D) + LN_EPS);
        u32x2* o8 = (u32x2*)(XN + (size_t)row * D) + lane;
#pragma unroll
        for (int j = 0; j < 4; ++j) { const f32x4 y = v[j] * rstd * gg[j] + bb[j]; xr[64 * j] = y; u32x2 w; w.x = cvt_pk_bf16(y[0], y[1]); w.y = cvt_pk_bf16(y[2], y[3]); o8[64 * j] = w; }
    }
}

__device__ __forceinline__ void attn_phase(LAS unsigned char* lds, const bf16_t* Q, const bf16_t* Kb, const bf16_t* Vb, const bf16_t* KS, const bf16_t* VS, bf16_t* O, const float* sinks, int G, int bid, int wave_s) {
    LAS bf16_t* Kl = (LAS bf16_t*)lds;
    LAS bf16_t* Vt = (LAS bf16_t*)(lds + 27648);
    int tid = wave_s * 64 + my_lane(); asm volatile("" : "+v"(tid));
    const int lane = tid & 63, wid = tid >> 6, fr = lane & 15, fq = lane >> 4;
    for (int u = bid; u < 1040; u += G) {
        int qrow0, kt0; const bf16_t* kbase; const bf16_t* vbase; int kvh;
        if (u < 1024) { const int b = u >> 7, c = (u >> 1) & 63; kvh = u & 1; qrow0 = b * 4096 + c * 64; kt0 = c >= 2 ? 0 : 2 - c;
            const long r0 = (long)b * 4096 + (long)(c - 2) * 64; kbase = Kb + r0 * 128 + kvh * 64; vbase = Vb + r0 * 128 + kvh * 64; }
        else { const int b = (u - 1024) >> 1; kvh = u & 1; qrow0 = MP + b * 64; kt0 = 0; kbase = KS + (size_t)b * 192 * 128 + kvh * 64; vbase = VS + (size_t)b * 192 * 128 + kvh * 64; }
        const int head = kvh * 8 + wid;
        bf16x8 qfa[4][2];
#pragma unroll
        for (int qt = 0; qt < 4; ++qt) { const size_t qoff = (size_t)(qrow0 + 16 * qt + fr) * D + head * 64; qfa[qt][0] = *(const bf16x8*)(Q + qoff + 8 * fq); qfa[qt][1] = *(const bf16x8*)(Q + qoff + 32 + 8 * fq); }
        u32x4 kvr[3], vvr[3];
#pragma unroll
        for (int i = 0; i < 3; ++i) {
            const int id = tid + 512 * i, row = id >> 3, pc = id & 7; const bool valid = (row >> 6) >= kt0;
            kvr[i] = (u32x4){0u, 0u, 0u, 0u}; vvr[i] = (u32x4){0u, 0u, 0u, 0u};
            if (valid) { kvr[i] = *(const u32x4*)(kbase + (long)row * 128 + pc * 8); vvr[i] = *(const u32x4*)(vbase + (long)row * 128 + pc * 8); }
        }
        asm volatile("s_waitcnt lgkmcnt(0)" ::: "memory"); __builtin_amdgcn_s_barrier(); asm volatile("" ::: "memory");
#pragma unroll
        for (int i = 0; i < 3; ++i) {
            const int id = tid + 512 * i, row = id >> 3, pc = id & 7;
            const u32x4 vv = vvr[i];
            *(LAS u32x4*)(Kl + row * 72 + pc * 8) = kvr[i];
            LAS bf16_t* vd = Vt + (pc * 8) * 200 + row;
            vd[0 * 200] = (bf16_t)(vv.x & 0xffffu); vd[1 * 200] = (bf16_t)(vv.x >> 16); vd[2 * 200] = (bf16_t)(vv.y & 0xffffu); vd[3 * 200] = (bf16_t)(vv.y >> 16);
            vd[4 * 200] = (bf16_t)(vv.z & 0xffffu); vd[5 * 200] = (bf16_t)(vv.z >> 16); vd[6 * 200] = (bf16_t)(vv.w & 0xffffu); vd[7 * 200] = (bf16_t)(vv.w >> 16);
        }
        asm volatile("s_waitcnt lgkmcnt(0)" ::: "memory"); __builtin_amdgcn_s_barrier(); asm volatile("" ::: "memory");
        const float sink = sinks[head] * 1.4426950408889634f;
#pragma unroll
        for (int qt = 0; qt < 4; ++qt) {
            const size_t qoff = (size_t)(qrow0 + 16 * qt + fr) * D + head * 64;
            bf16x8 qf[2];
            qf[0] = qfa[qt][0]; qf[1] = qfa[qt][1];
            f32x4 S[12];
#pragma unroll
            for (int kt = 0; kt < 12; ++kt) {
                S[kt] = (f32x4){0.f, 0.f, 0.f, 0.f};
#pragma unroll
                for (int ks = 0; ks < 2; ++ks) { const bf16x8 kf = *(const LAS bf16x8*)(Kl + (16 * kt + fr) * 72 + 32 * ks + 8 * fq); S[kt] = __builtin_amdgcn_mfma_f32_16x16x32_bf16(kf, qf[ks], S[kt], 0, 0, 0); }
            }
            if (kt0 > 0) {
#pragma unroll
                for (int kt = 0; kt < 8; ++kt) if (kt < 4 * kt0) S[kt] = (f32x4){-1e30f, -1e30f, -1e30f, -1e30f};
            }
            float mx = sink;
#pragma unroll
            for (int kt = 0; kt < 12; ++kt) mx = fmaxf(fmaxf(fmaxf(mx, S[kt][0]), fmaxf(S[kt][1], S[kt][2])), S[kt][3]);
            mx = fmaxf(mx, __shfl_xor(mx, 16)); mx = fmaxf(mx, __shfl_xor(mx, 32));
            float sum = 0.f;
#pragma unroll
            for (int kt = 0; kt < 12; ++kt) {
#pragma unroll
                for (int i = 0; i < 4; ++i) { const float p = __builtin_amdgcn_exp2f(S[kt][i] - mx); S[kt][i] = p; sum += p; }
            }
            sum += __shfl_xor(sum, 16); sum += __shfl_xor(sum, 32);
            sum += __builtin_amdgcn_exp2f(sink - mx);
            const float inv = 1.f / sum;
            f32x4 Oa[4];
#pragma unroll
            for (int dt = 0; dt < 4; ++dt) Oa[dt] = (f32x4){0.f, 0.f, 0.f, 0.f};
#pragma unroll
            for (int kb = 0; kb < 6; ++kb) {
                u32x4 pw; pw.x = cvt_pk_bf16(S[2 * kb][0], S[2 * kb][1]); pw.y = cvt_pk_bf16(S[2 * kb][2], S[2 * kb][3]);
                pw.z = cvt_pk_bf16(S[2 * kb + 1][0], S[2 * kb + 1][1]); pw.w = cvt_pk_bf16(S[2 * kb + 1][2], S[2 * kb + 1][3]);
                const bf16x8 pf = __builtin_bit_cast(bf16x8, pw);
#pragma unroll
                for (int dt = 0; dt < 4; ++dt) {
                    const LAS bf16_t* vp = Vt + (16 * dt + fr) * 200 + 32 * kb + 4 * fq;
                    const u32x2 lo = *(const LAS u32x2*)vp, hi = *(const LAS u32x2*)(vp + 16);
                    const u32x4 vw = (u32x4){lo.x, lo.y, hi.x, hi.y};
                    Oa[dt] = __builtin_amdgcn_mfma_f32_16x16x32_bf16(__builtin_bit_cast(bf16x8, vw), pf, Oa[dt], 0, 0, 0);
                }
            }
#pragma unroll
            for (int dt = 0; dt < 4; ++dt) { const f32x4 o = Oa[dt] * inv; u32x2 w; w.x = cvt_pk_bf16(o[0], o[1]); w.y = cvt_pk_bf16(o[2], o[3]); *(u32x2*)(O + qoff + 16 * dt + 4 * fq) = w; }
        }
    }
}

__device__ __forceinline__ void ssm_ktab(LAS unsigned char* lds, const float* cre, const float* cim, const float* lamP, const float* Bb, float* Ktab, int G, int bid, int wave_s) {
    int tid = wave_s * 64 + my_lane(); asm volatile("" : "+v"(tid));
    LAS f32x2* Cl = (LAS f32x2*)lds;
    LAS f32x2* Bl = (LAS f32x2*)(lds + 8192);
    LAS f32x2* Ll = (LAS f32x2*)(lds + 16384);
    for (int it = bid; it < 256; it += G) {
        const int g = it >> 2, t0 = (it & 3) * 16;
        __syncthreads();
        for (int e = tid; e < 1024; e += 512) {
            Cl[e] = (f32x2){cre[g * 1024 + e], cim[g * 1024 + e]};
            Bl[e] = *(const f32x2*)(Bb + ((size_t)g * 1024 + e) * 2);
            const int p = e >> 4, tt = e & 15; Ll[e] = *(const f32x2*)(lamP + ((size_t)(g * 64 + p) * 65 + t0 + tt) * 2);
        }
        __syncthreads();
        const int c = (tid >> 4) & 15, cp = tid & 15, th = tid >> 8;
        float acc[8];
#pragma unroll
        for (int r = 0; r < 8; ++r) acc[r] = 0.f;
#pragma unroll 4
        for (int p = 0; p < 64; ++p) {
            const f32x2 cc = Cl[c * 64 + p], bb = Bl[p * 16 + cp];
            const float uu = cc.x * bb.x - cc.y * bb.y, vv = cc.y * bb.x + cc.x * bb.y;
#pragma unroll
            for (int r = 0; r < 8; ++r) { const f32x2 lm = Ll[p * 16 + r * 2 + th]; acc[r] += lm.x * uu - lm.y * vv; }
        }
#pragma unroll
        for (int r = 0; r < 8; ++r) Ktab[((size_t)(g * 64 + t0 + r * 2 + th) * 16 + c) * 16 + cp] = acc[r];
    }
    __syncthreads();
}
__device__ __forceinline__ void ssm_w1t(const float* lamP, const float* Bb, bf16_t* W1t, int G, int bid, int wave_s) {
    int tid_ = wave_s * 64 + my_lane(); asm volatile("" : "+v"(tid_));
    const int gt = bid * 512 + tid_, NGT = G * 512;
    for (int e0 = gt; e0 < 64 * 128 * 128; e0 += 2 * NGT) {
        f32x2 lm[2]; f32x4 b0[2][2], b1[2][2];
#pragma unroll
        for (int h = 0; h < 2; ++h) {
            const int e = e0 + h * NGT, k8 = e & 127, n = (e >> 7) & 127, g = e >> 14, p = n >> 1, j = k8 >> 1, c0 = (k8 & 1) * 8;
            if (e < 64 * 128 * 128) {
                lm[h] = *(const f32x2*)(lamP + ((size_t)(g * 64 + p) * 65 + (63 - j)) * 2);
                const float* bp = Bb + ((size_t)(g * 64 + p) * 16 + c0) * 2;
                b0[h][0] = *(const f32x4*)bp; b0[h][1] = *(const f32x4*)(bp + 4); b1[h][0] = *(const f32x4*)(bp + 8); b1[h][1] = *(const f32x4*)(bp + 12);
            }
        }
#pragma unroll
        for (int h = 0; h < 2; ++h) {
            const int e = e0 + h * NGT, k8 = e & 127, n = (e >> 7) & 127, g = e >> 14, ri = n & 1;
            if (e < 64 * 128 * 128) {
                const f32x4 q0 = b0[h][0], q1 = b0[h][1], q2 = b1[h][0], q3 = b1[h][1];
                const float br[8] = {q0[0], q0[2], q1[0], q1[2], q2[0], q2[2], q3[0], q3[2]}, bi[8] = {q0[1], q0[3], q1[1], q1[3], q2[1], q2[3], q3[1], q3[3]};
                float v[8];
#pragma unroll
                for (int q = 0; q < 8; ++q) v[q] = ri ? (lm[h].x * bi[q] + lm[h].y * br[q]) : (lm[h].x * br[q] - lm[h].y * bi[q]);
                u32x4 w; w.x = cvt_pk_bf16(v[0], v[1]); w.y = cvt_pk_bf16(v[2], v[3]); w.z = cvt_pk_bf16(v[4], v[5]); w.w = cvt_pk_bf16(v[6], v[7]);
                *(u32x4*)(W1t + ((size_t)(g * 128 + n) * 1024) + k8 * 8) = w;
            }
        }
    }
}
__device__ __forceinline__ void ssm_toep(const float* cre, const float* cim, const float* lamP, const float* Ktab, bf16_t* T, int tri, int G, int bid, int wave_s) {
    int tid_ = wave_s * 64 + my_lane(); asm volatile("" : "+v"(tid_));
    const int gt = bid * 512 + tid_, NGT = G * 512;
    const int lane_ = gt & 63, gw_ = gt >> 6, NGW_ = NGT >> 6;
    for (int r0 = gw_ * 4; r0 < 64 * 1024; r0 += NGW_ * 4) {
        f32x4 a0[8], a1[8];
#pragma unroll
        for (int j = 0; j < 8; ++j) {
            const int gn = r0 + (j >> 1), k8 = 16 + ((lane_ + 64 * j) & 127), g = gn >> 10, n = gn & 1023, t = n >> 4, c = n & 15, jj = (k8 - 16) >> 1, c0 = (k8 & 1) * 8;
            a0[j] = (f32x4){0.f, 0.f, 0.f, 0.f}; a1[j] = (f32x4){0.f, 0.f, 0.f, 0.f};
            if (jj <= t) { const float* kp = Ktab + ((size_t)(g * 64 + (t - jj)) * 16 + c) * 16 + c0; a0[j] = *(const f32x4*)kp; a1[j] = *(const f32x4*)(kp + 4); }
        }
        const int gnb = r0 + (lane_ >> 4), k8b = lane_ & 15, gb = gnb >> 10, nb = gnb & 1023, tb = nb >> 4, cb = nb & 15, p0 = k8b * 4;
        const f32x4 crv = *(const f32x4*)(cre + (gb * 16 + cb) * 64 + p0), civ = *(const f32x4*)(cim + (gb * 16 + cb) * 64 + p0);
        f32x2 lm[4];
#pragma unroll
        for (int q = 0; q < 4; ++q) lm[q] = *(const f32x2*)(lamP + ((size_t)(gb * 64 + p0 + q) * 65 + (tb + 1)) * 2);
#pragma unroll
        for (int j = 0; j < 8; ++j) {
            const int gn = r0 + (j >> 1), k8 = 16 + ((lane_ + 64 * j) & 127), t = (gn & 1023) >> 4;
            if (tri && k8 >= 16 + 32 * ((t >> 4) + 1)) continue;
            u32x4 w; w.x = cvt_pk_bf16(a0[j][0], a0[j][1]); w.y = cvt_pk_bf16(a0[j][2], a0[j][3]); w.z = cvt_pk_bf16(a1[j][0], a1[j][1]); w.w = cvt_pk_bf16(a1[j][2], a1[j][3]);
            *(u32x4*)(T + (size_t)gn * KT + k8 * 8) = w;
        }
        {
            float v[8];
#pragma unroll
            for (int q = 0; q < 4; ++q) { v[2 * q] = crv[q] * lm[q].x - civ[q] * lm[q].y; v[2 * q + 1] = -(crv[q] * lm[q].y + civ[q] * lm[q].x); }
            u32x4 w; w.x = cvt_pk_bf16(v[0], v[1]); w.y = cvt_pk_bf16(v[2], v[3]); w.z = cvt_pk_bf16(v[4], v[5]); w.w = cvt_pk_bf16(v[6], v[7]);
            *(u32x4*)(T + (size_t)gnb * KT + k8b * 8) = w;
        }
    }
}
__device__ __forceinline__ void scan_one(const float* DS, const float* lamP, bf16_t* U, const float* sre, const float* sim, float* orep, float* oimp, float* ores, float* oims, int p, int g, int b, int smp) {
    const f32x2 l64 = *(const f32x2*)(lamP + ((size_t)(g * 64 + p) * 65 + 64) * 2);
    const int oidx = (b * 64 + g) * 64 + p;
    if (!smp) {
        float sr = 0.f, si = 0.f;
        const size_t r0 = (size_t)(g * NBC + b * 64);
#pragma unroll 1
        for (int c0 = 0; c0 < 64; c0 += 16) {
            f32x2 d[16];
#pragma unroll
            for (int q = 0; q < 16; ++q) d[q] = *(const f32x2*)(DS + (r0 + c0 + q) * 128 + 2 * p);
#pragma unroll
            for (int q = 0; q < 16; ++q) {
                *(unsigned*)(U + (r0 + c0 + q) * KT + 2 * p) = cvt_pk_bf16(sr, si);
                const float nr = l64.x * sr - l64.y * si + d[q].x, ni = l64.x * si + l64.y * sr + d[q].y; sr = nr; si = ni;
            }
        }
        orep[oidx] = sr; oimp[oidx] = si;
    } else {
        const float sr = sre[oidx], si = sim[oidx];
        const size_t r = (size_t)(g * NBC + 512 + b);
        *(unsigned*)(U + r * KT + 2 * p) = cvt_pk_bf16(sr, si);
        const f32x2 d = *(const f32x2*)(DS + r * 128 + 2 * p);
        ores[oidx] = l64.x * sr - l64.y * si + d.x; oims[oidx] = l64.x * si + l64.y * sr + d.y;
    }
}
__device__ __forceinline__ void ssm_scan(const float* DS, const float* lamP, bf16_t* U, const float* sre, const float* sim, float* orep, float* oimp, float* ores, float* oims, int G, int bid, int wave_s) {
    int tid_ = wave_s * 64 + my_lane(); asm volatile("" : "+v"(tid_));
    const int gt = bid * 512 + tid_, NGT = G * 512;
    for (int w = gt; w < 2 * 8 * 64 * 64; w += NGT) scan_one(DS, lamP, U, sre, sim, orep, oimp, ores, oims, w & 63, (w >> 6) & 63, (w >> 12) & 7, w >> 15);
}
__device__ __forceinline__ void ssm_scan_local(const float* DS, const float* lamP, bf16_t* U, const float* sre, const float* sim, float* orep, float* oimp, float* ores, float* oims, int g, int pm, int wave_s) {
    int tid_ = wave_s * 64 + my_lane(); asm volatile("" : "+v"(tid_));
    if (pm < 2) { if (tid_ < 256) scan_one(DS, lamP, U, sre, sim, orep, oimp, ores, oims, tid_ & 63, g, 4 * pm + (tid_ >> 6), 0); }
    else scan_one(DS, lamP, U, sre, sim, orep, oimp, ores, oims, tid_ & 63, g, tid_ >> 6, 1);
}


constexpr size_t WS_BAR = WS_CNT + 65536;
#define XB_TMO      128
#define XB_XCNT(j)  (256  + 64 * (j))
#define XB_XSUB(j)  (1280 + 64 * (j))
#define XB_XGEN(j)  (2304 + 64 * (j))
#define XB_TOP      3328
#define XB_TOPGEN   3392
#define XCD_BAR_WORDS 3456
#define XB_SPIN_CAP (1u << 22)
__device__ __forceinline__ unsigned xb_ld(unsigned* p)              { return __hip_atomic_load(p, __ATOMIC_RELAXED, __HIP_MEMORY_SCOPE_AGENT); }
__device__ __forceinline__ unsigned xb_add(unsigned* p, unsigned v) { return __hip_atomic_fetch_add(p, v, __ATOMIC_RELAXED, __HIP_MEMORY_SCOPE_AGENT); }
__device__ __forceinline__ unsigned xb_xcc_id() { return (unsigned)__builtin_amdgcn_s_getreg((3 << 11) | 20) & 0xFu; }
#define XB_SPIN(cond, bar) do { unsigned _sp = 0; while (cond) { __builtin_amdgcn_s_sleep(1); \
    if ((++_sp & 255u) == 0u) { if (xb_ld(&(bar)[XB_TMO])) break; if (_sp > XB_SPIN_CAP) { atomicAdd(&(bar)[XB_TMO], 1u); break; } } } } while (0)
__device__ __forceinline__ void xcd_barrier_complete(unsigned* bar, unsigned x, unsigned G, unsigned& nloc, unsigned& nx) {
    unsigned sum, cnt, mine, sp = 0u;
    for (;;) {
        sum = 0u; cnt = 0u; mine = 0u;
#pragma unroll
        for (unsigned j = 0; j < 16; ++j) { const unsigned c = xb_ld(&bar[XB_XCNT(j)]); sum += c; cnt += (c > 0u) ? 1u : 0u; mine = (j == x) ? c : mine; }
        if (sum == G) break;
        __builtin_amdgcn_s_sleep(1);
        if ((++sp & 255u) == 0u) { if (xb_ld(&bar[XB_TMO])) break; if (sp > XB_SPIN_CAP) { atomicAdd(&bar[XB_TMO], 1u); break; } }
    }
    nloc = mine > 0u ? mine : 1u; nx = cnt > 0u ? cnt : 1u;
}
__device__ __forceinline__ void xcd_barrier(unsigned* bar, volatile LAS unsigned* st, bool leader, unsigned G) {
    asm volatile("s_waitcnt vmcnt(0)" ::: "memory");
    __syncthreads();
    if (leader) {
        __builtin_amdgcn_s_waitcnt(0);
        const unsigned x = xb_xcc_id();
        unsigned nloc = st[0], nx = st[1];
        if (nloc == 0u) { xcd_barrier_complete(bar, x, G, nloc, nx); st[0] = nloc; st[1] = nx; }
        const unsigned old = xb_add(&bar[XB_XSUB(x)], 1u);
        const unsigned gen = old / nloc;
        if (old + 1u == (gen + 1u) * nloc) {
            __builtin_amdgcn_fence(__ATOMIC_RELEASE, "agent");
            asm volatile("s_waitcnt vmcnt(0)" ::: "memory");
            const unsigned og = xb_add(&bar[XB_TOP], 1u);
            const unsigned tg = og / nx;
            if (og + 1u == (tg + 1u) * nx) xb_add(&bar[XB_TOPGEN], 1u);
            else XB_SPIN(xb_ld(&bar[XB_TOPGEN]) == tg, bar);
            __builtin_amdgcn_fence(__ATOMIC_ACQUIRE, "agent");
            xb_add(&bar[XB_XGEN(x)], 1u);
            asm volatile("s_waitcnt vmcnt(0)" ::: "memory");
        } else {
            XB_SPIN(xb_ld(&bar[XB_XGEN(x)]) == gen, bar);
            __builtin_amdgcn_fence(__ATOMIC_ACQUIRE, "agent");
            asm volatile("s_waitcnt vmcnt(0)" ::: "memory");
        }
    }
    __syncthreads();
}

constexpr int LDS_BYTES = 144 * 1024;

__global__ void __launch_bounds__(512, 2) mega_fwd(Args a) {
    extern __shared__ __attribute__((aligned(16))) unsigned char lds_raw[];
    LAS unsigned char* lds = (LAS unsigned char*)lds_raw;
    cg::grid_group grid = cg::this_grid();
    const int wave_s = __builtin_amdgcn_readfirstlane((int)threadIdx.x >> 6);
    volatile LAS unsigned* bar_st = (volatile LAS unsigned*)(lds + 131072 + 12288);
    unsigned* const bar_words = (unsigned*)(a.ws + WS_BAR);
    {
        const int t0 = threadIdx.x;
        if (t0 < 2) bar_st[t0] = 0u;
        if (blockIdx.x == 0) for (int e = t0; e < XCD_BAR_WORDS; e += 512) __hip_atomic_store(bar_words + e, 0u, __ATOMIC_RELAXED, __HIP_MEMORY_SCOPE_AGENT);
        grid.sync();
        if (t0 == 0) (void)xb_add(&bar_words[XB_XCNT(xb_xcc_id())], 1u);
    }
    int ph = 0;
#define PH_BEGIN if (ph >= a.ph_lo && ph < a.ph_hi) { size_t zo_ = 0; asm volatile("" : "+s"(zo_));   \
        unsigned char* ws = a.ws + zo_; float* X = (float*)((unsigned char*)a.out + zo_); int G = gridDim.x, bid = blockIdx.x; \
        asm volatile("" : "+s"(G), "+s"(bid), "+s"(layer)); const int l = layer >> 1; (void)l; \
        bf16_t* XN = (bf16_t*)(ws + WS_XN); bf16_t* Hb = (bf16_t*)(ws + WS_H); (void)XN; (void)Hb; float* OUT = X; (void)OUT;
#define PH_END if (ph + 1 < a.ph_hi) xcd_barrier(bar_words, bar_st, wave_s == 0 && my_lane() == 0, (unsigned)G); } ++ph;
#define ATT_PTRS bf16_t* Qb = (bf16_t*)(ws + WS_Q); bf16_t* Ob = (bf16_t*)(ws + WS_O); bf16_t* Kb = (bf16_t*)(ws + WS_K); bf16_t* Vb = (bf16_t*)(ws + WS_V); \
        bf16_t* KS = (bf16_t*)(ws + WS_KS) + (size_t)l * 8 * 192 * 128; bf16_t* VS = (bf16_t*)(ws + WS_VS) + (size_t)l * 8 * 192 * 128; (void)Qb; (void)Ob; (void)Kb; (void)Vb; (void)KS; (void)VS;
#define SSM_PTRS bf16_t* U = (bf16_t*)(ws + WS_U); bf16_t* ZG = (bf16_t*)(ws + WS_ZG); float* DS = (float*)(ws + WS_DS); \
        bf16_t* T = (bf16_t*)(ws + WS_T); bf16_t* W1t = (bf16_t*)(ws + WS_W1T); float* Ktab = (float*)(ws + WS_KTAB); \
        const float* lamP = (const float*)(ws + WS_LAMP) + (size_t)l * 64 * 64 * 65 * 2; const float* Bb = (const float*)(ws + WS_BB) + (size_t)l * 64 * 64 * 16 * 2; \
        const float* cre = a.in[I_CRE] + (size_t)l * 65536; const float* cim = a.in[I_CIM] + (size_t)l * 65536; \
        (void)U; (void)ZG; (void)DS; (void)T; (void)W1t; (void)Ktab; (void)lamP; (void)Bb; (void)cre; (void)cim;

    { int layer = 0;
    PH_BEGIN
#ifndef SKIP_PRO
        prologue(a, lds, G, bid, wave_s);
#endif
    PH_END }

#define DEFERRED_DOWN() do { const int pl = layer - 1; \
        pg8::Gemm gd{Hb, (const bf16_t*)(ws + WS_WDN) + (size_t)pl * D * DFF, DFF, DFF, DFF, 0, 0}; pg8::OneUnit Sd{128 + ((bid - 248) >> 2), (bid - 248) & 3}; \
        EpiResidLN<false> Ed{nullptr, X, XN, LnX{(unsigned long long*)(ws + WS_XBUF), (unsigned)(pl * 2 + 2), a.in[I_LNG] + (size_t)(pl * 2 + 1) * D, a.in[I_LNB] + (size_t)(pl * 2 + 1) * D, lds + 131072}}; \
        pg8::gemm_phase(lds, gd, Sd, Ed, wave_s); \
        asm volatile("s_waitcnt vmcnt(0)" ::: "memory"); __syncthreads(); \
        if (wave_s == 0) { __builtin_amdgcn_fence(__ATOMIC_RELEASE, "agent"); asm volatile("s_waitcnt vmcnt(0)" ::: "memory"); \
                           if (my_lane() == 0) __hip_atomic_fetch_add((unsigned*)(ws + WS_CNT) + layer, 1u, __ATOMIC_RELAXED, __HIP_MEMORY_SCOPE_AGENT); } } while (0)
#define WAIT_DEFERRED_DOWN() do { if (wave_s == 0) { unsigned sp_ = 0; \
            while ((unsigned)__builtin_amdgcn_readfirstlane(__hip_atomic_load((unsigned*)(ws + WS_CNT) + layer, __ATOMIC_RELAXED, __HIP_MEMORY_SCOPE_AGENT)) < 8u) { __builtin_amdgcn_s_sleep(2); if (++sp_ > (1u << 20)) break; } \
            __builtin_amdgcn_fence(__ATOMIC_ACQUIRE, "agent"); } \
        asm volatile("s_waitcnt vmcnt(0) lgkmcnt(0)" ::: "memory"); __syncthreads(); } while (0)
    for (int layer = 0; layer < 4; ++layer) {
        if ((layer & 1) == 0) {
            PH_BEGIN { ATT_PTRS
                const int defer = (G == 256 && layer > 0) ? 1 : 0;
                if (defer && bid >= 248) { DEFERRED_DOWN(); }
                else {
                pg8::Gemm g{XN, (const bf16_t*)(ws + WS_WQKV) + (size_t)l * NQKV * D, D, D, D, 0, 0}; pg8::StaticOrder S; S.init(defer ? MP : MT, NQKV, defer ? 248 : G, bid);
                EpiQKV E{a.in[I_BQKV] + l * NQKV, (const float*)(ws + WS_ROPE), Qb, Kb, Vb, KS, VS, OUT + O_KP + (size_t)l * 131072, OUT + O_VP + (size_t)l * 131072,
                         OUT + O_KSM + (size_t)l * 131072, OUT + O_VSM + (size_t)l * 131072};
#ifndef SKIP_QKV
                pg8::gemm_phase(lds, g, S, E, wave_s);
                if (defer && bid >= 144 && bid < 154) {
                    WAIT_DEFERRED_DOWN();
                    pg8::OneUnit S2{128 + (bid - 144) / 5, (bid - 144) % 5};
                    pg8::gemm_phase(lds, g, S2, E, wave_s);
                }
#endif
                }
            } PH_END
            PH_BEGIN { ATT_PTRS
#ifndef SKIP_ATT
                attn_phase(lds, Qb, Kb, Vb, KS, VS, Ob, a.in[I_SINK] + l * 16, G, bid, wave_s);
#endif
            } PH_END
            PH_BEGIN { ATT_PTRS
                pg8::Gemm g{Ob, (const bf16_t*)(ws + WS_WO) + (size_t)l * D * D, D, D, D, 0, 0}; pg8::PanelOrder S; S.init(MT, D, G, bid);
                EpiResidLN<false> E{a.in[I_BO] + l * D, X, XN,
                             LnX{(unsigned long long*)(ws + WS_XBUF), (unsigned)(layer * 2 + 1), a.in[I_LNG] + (size_t)(layer * 2) * D, a.in[I_LNB] + (size_t)(layer * 2) * D, lds + 131072}};
#ifndef SKIP_WO
                pg8::gemm_phase(lds, g, S, E, wave_s);
#endif
            } PH_END
        } else {
            PH_BEGIN { SSM_PTRS
                const int defer = (G == 256) ? 1 : 0;
                if (defer && bid >= 248) { DEFERRED_DOWN(); }
                else {
                pg8::Gemm g{XN, (const bf16_t*)(ws + WS_WIN) + (size_t)l * D * D, D, D, D, 0, 0}; pg8::StaticOrder S; S.init(defer ? MP : MT, D, defer ? 248 : G, bid);
                EpiSsmIn E{a.in[I_BIN] + l * D, U};
#ifndef SKIP_IN
                pg8::gemm_phase(lds, g, S, E, wave_s);
                if (defer && bid >= 16 && bid < 24) {
                    WAIT_DEFERRED_DOWN();
                    pg8::OneUnit S2{128 + ((bid - 16) >> 2), (bid - 16) & 3};
                    pg8::gemm_phase(lds, g, S2, E, wave_s);
                }
#endif
                }
                ssm_ktab(lds, cre, cim, lamP, Bb, Ktab, G, bid, wave_s);
                ssm_w1t(lamP, Bb, W1t, G, bid, wave_s);
            } PH_END
            PH_BEGIN { SSM_PTRS
                pg8::Gemm g{U + 128, W1t, 1024, KT, 1024, (size_t)NBC * KT, (size_t)128 * 1024}; pg8::GroupOrder S; S.init(3, 1, 64, G, bid, 0);
                EpiDS E{DS};
#ifndef SKIP_DS
                pg8::gemm_phase(lds, g, S, E, wave_s);
#endif
                if (G == 256) {
                    const int vc = (bid & 7) * 32 + (bid >> 3);
                    if (vc < 192) ssm_scan_local(DS, lamP, U, a.in[I_SRE] + (size_t)l * 32768, a.in[I_SIM] + (size_t)l * 32768, OUT + O_REP + (size_t)l * 32768, OUT + O_IMP + (size_t)l * 32768,
                                                 OUT + O_RES + (size_t)l * 32768, OUT + O_IMS + (size_t)l * 32768, vc / 3, vc % 3, wave_s);
                }
                ssm_toep(cre, cim, lamP, Ktab, T, G == 256 ? 1 : 0, G, bid, wave_s);
            } PH_END
            if ((int)gridDim.x != 256) { PH_BEGIN { SSM_PTRS
                ssm_scan(DS, lamP, U, a.in[I_SRE] + (size_t)l * 32768, a.in[I_SIM] + (size_t)l * 32768, OUT + O_REP + (size_t)l * 32768, OUT + O_IMP + (size_t)l * 32768,
                         OUT + O_RES + (size_t)l * 32768, OUT + O_IMS + (size_t)l * 32768, G, bid, wave_s);
            } PH_END }
            PH_BEGIN { SSM_PTRS
                pg8::Gemm g{U, T, KT, KT, KT, (size_t)NBC * KT, (size_t)1024 * KT}; pg8::GroupOrder S; S.init(3, 4, 64, G, bid, G == 256 ? 1 : 0);
                EpiToep E{U, a.in[I_SD] + l * D, ZG};
#ifndef SKIP_TOEP
                pg8::gemm_phase(lds, g, S, E, wave_s);
#endif
            } PH_END
            PH_BEGIN { SSM_PTRS
                pg8::Gemm g{ZG, (const bf16_t*)(ws + WS_WGLU) + (size_t)l * 2 * D * D, D, D, D, 0, 0}; pg8::PanelOrder S; S.init(MT, 2 * D, G, bid);
                EpiGLULN E{a.in[I_BGLU] + l * 2 * D, XN,
                           LnX{(unsigned long long*)(ws + WS_XBUF), (unsigned)(layer * 2 + 1), a.in[I_LNG] + (size_t)(layer * 2) * D, a.in[I_LNB] + (size_t)(layer * 2) * D, lds + 131072}};
#ifndef SKIP_GLU
                pg8::gemm_phase(lds, g, S, E, wave_s);
#endif
            } PH_END
        }
        PH_BEGIN {
            const int defer3 = (G == 256 && layer == 3) ? 1 : 0;
            unsigned* upcnt = (unsigned*)(ws + WS_CNT) + 16;
            if (defer3 && bid >= 248) {
                if (wave_s == 0) { unsigned sp_ = 0;
                    while ((unsigned)__builtin_amdgcn_readfirstlane(__hip_atomic_load(upcnt, __ATOMIC_RELAXED, __HIP_MEMORY_SCOPE_AGENT)) < 44u) { __builtin_amdgcn_s_sleep(4); if (++sp_ > (1u << 20)) break; }
                    __builtin_amdgcn_fence(__ATOMIC_ACQUIRE, "agent"); }
                asm volatile("s_waitcnt vmcnt(0) lgkmcnt(0)" ::: "memory"); __syncthreads();
                pg8::Gemm gd{Hb, (const bf16_t*)(ws + WS_WDN) + (size_t)layer * D * DFF, DFF, DFF, DFF, 0, 0}; pg8::OneUnit Sd{128 + ((bid - 248) >> 2), (bid - 248) & 3};
                EpiResidLN<true> Ed{nullptr, X, XN, LnX{(unsigned long long*)(ws + WS_XBUF), (unsigned)(layer * 2 + 2), a.in[I_LNG] + (size_t)(layer * 2 + 1) * D, a.in[I_LNB] + (size_t)(layer * 2 + 1) * D, lds + 131072}};
#ifndef SKIP_DN
                pg8::gemm_phase(lds, gd, Sd, Ed, wave_s);
#endif
            } else {
            pg8::Gemm g{XN, (const bf16_t*)(ws + WS_WUP) + (size_t)layer * NUP * D, D, D, D, 0, 0};
            pg8::PrefixOrder S; S.base.init(defer3 ? MP : MT, NUP, defer3 ? 248 : G, bid); S.has = (defer3 && bid >= 88 && bid < 132) ? 1 : 0; S.pm = 128 + (bid - 88) / 22; S.pn = (bid - 88) % 22;
            EpiSwiGLU E{Hb, defer3 ? upcnt : nullptr};
#ifndef SKIP_UP
            pg8::gemm_phase(lds, g, S, E, wave_s);
#endif
            }
        } PH_END
        PH_BEGIN {
            pg8::Gemm g{Hb, (const bf16_t*)(ws + WS_WDN) + (size_t)layer * D * DFF, DFF, DFF, DFF, 0, 0}; pg8::PanelOrder S; S.init((G == 256) ? MP : MT, D, G, bid);
            const LnX LX = LnX{(unsigned long long*)(ws + WS_XBUF), (unsigned)(layer * 2 + 2), a.in[I_LNG] + (size_t)(layer * 2 + 1) * D, a.in[I_LNB] + (size_t)(layer * 2 + 1) * D, lds + 131072};
#ifndef SKIP_DN
            if (layer == 3) { EpiResidLN<true> E{nullptr, X, XN, LX}; pg8::gemm_phase(lds, g, S, E, wave_s); }
            else { EpiResidLN<false> E{nullptr, X, XN, LX}; pg8::gemm_phase(lds, g, S, E, wave_s); }
#endif
        } PH_END
    }
}

extern "C" void kernel_launch(void* const* d_in, const int* in_sizes, int n_in, void* d_out, int out_size, void* d_ws, size_t ws_size, hipStream_t stream) {
    static int grid = 0;
    if (grid == 0) {
        if (n_in != N_IN || ws_size < WS_END2) { fprintf(stderr, "kernel_launch: unexpected n_in %d / ws_size %zu\n", n_in, ws_size); grid = -1; return; }
        int dev = 0, cus = 0, per_cu = 0;
        hipGetDevice(&dev); hipDeviceGetAttribute(&cus, hipDeviceAttributeMultiprocessorCount, dev);
        if (hipFuncSetAttribute((const void*)mega_fwd, hipFuncAttributeMaxDynamicSharedMemorySize, LDS_BYTES) != hipSuccess) { fprintf(stderr, "kernel_launch: hipFuncSetAttribute failed\n"); grid = -1; return; }
        hipOccupancyMaxActiveBlocksPerMultiprocessor(&per_cu, (const void*)mega_fwd, 512, LDS_BYTES);
        (void)hipGetLastError();
        if (per_cu < 1) fprintf(stderr, "kernel_launch: occupancy query says %d blocks per CU\n", per_cu);
        grid = cus > 0 ? cus : 256;
    }
    if (grid < 0) return;
    Args a{};
    for (int i = 0; i < N_IN; ++i) a.in[i] = (const float*)d_in[i];
    a.out = (float*)d_out; a.ws = (unsigned char*)d_ws; a.ph_lo = 0; a.ph_hi = 1000;
    void* args[] = {&a};
    hipError_t e = hipLaunchCooperativeKernel((const void*)mega_fwd, dim3(grid), dim3(512), args, LDS_BYTES, stream);
    if (e != hipSuccess) fprintf(stderr, "cooperative launch failed: %s (grid %d)\n", hipGetErrorString(e), grid);
}
```

```cpp
#include <hip/hip_runtime.h>
#include <hip/hip_cooperative_groups.h>
#include <cstdio>
#include <cstdint>
namespace cg = cooperative_groups;

#define LAS __attribute__((address_space(3)))
typedef unsigned short bf16_t;
typedef short bf16x8 __attribute__((ext_vector_type(8)));
typedef float f32x4 __attribute__((ext_vector_type(4)));
typedef float f32x2 __attribute__((ext_vector_type(2)));
typedef unsigned u32x4 __attribute__((ext_vector_type(4)));
typedef unsigned u32x2 __attribute__((ext_vector_type(2)));

constexpr int D = 1024, MP = 32768, MS = 512, MT = MP + MS, NQKV = 1280, DFF = 2816, NUP = 2 * DFF;
constexpr int NBC = 520;
constexpr int KT = 1152;
constexpr float ALPHA = 1.6817928305074290f;
constexpr float LN_EPS = 1e-5f;

enum { I_XP = 0, I_XS, I_CK, I_CV, I_SRE, I_SIM, I_WQKV, I_BQKV, I_SINK, I_WO, I_BO, I_WIN, I_BIN, I_LOGDT, I_ARE, I_AIM, I_BRE, I_BIM, I_CRE, I_CIM,
       I_SD, I_WGLU, I_BGLU, I_WUP, I_WDN, I_LNG, I_LNB, N_IN };

constexpr size_t O_YS = 33554432, O_KP = 34078720, O_VP = 34340864, O_REP = 34603008, O_IMP = 34668544, O_KSM = 34734080, O_VSM = 34996224,
                 O_RES = 35258368, O_IMS = 35323904;

constexpr size_t MiB = 1u << 20;
constexpr size_t WS_WQKV = 0, WS_WO = 5 * MiB, WS_WIN = 9 * MiB, WS_WGLU = 13 * MiB, WS_WUP = 21 * MiB, WS_WDN = 65 * MiB;
constexpr size_t WS_XN = 87 * MiB, WS_H = 152 * MiB;
constexpr size_t WS_Q = WS_H, WS_O = WS_H + 65 * MiB, WS_K = WS_H + 130 * MiB, WS_V = WS_H + 138 * MiB;
constexpr size_t WS_U = WS_H, WS_ZG = WS_H + 74 * MiB, WS_DS = WS_H + 139 * MiB;
constexpr size_t WS_T = 331 * MiB, WS_W1T = 475 * MiB, WS_KTAB = 492 * MiB, WS_LAMP = 496 * MiB, WS_BB = 501 * MiB, WS_ROPE = 502 * MiB, WS_KS = 504 * MiB,
                 WS_VS = 505 * MiB, WS_END = 506 * MiB;

__device__ __forceinline__ unsigned cvt_pk_bf16(float lo, float hi) { unsigned r; asm volatile("v_cvt_pk_bf16_f32 %0, %1, %2" : "=v"(r) : "v"(lo), "v"(hi)); return r; }
__device__ __forceinline__ int my_lane() { int l; asm volatile("v_mbcnt_lo_u32_b32 %0, -1, 0\n\tv_mbcnt_hi_u32_b32 %0, -1, %0" : "=v"(l)); return l; }
__device__ __forceinline__ float bf2f(unsigned short b) { return __uint_as_float((unsigned)b << 16); }
__device__ __forceinline__ float bflo(unsigned w) { return __uint_as_float(w << 16); }
__device__ __forceinline__ float bfhi(unsigned w) { return __uint_as_float(w & 0xffff0000u); }

namespace pg8 {
constexpr int BM = 256, BK = 64, HALF = 128, HTB = HALF * BK * 2, STAGE_BYTES = 8 * HTB, NXCD = 8, WGM = 8;
__host__ __device__ __forceinline__ int lds_byte(int r, int c) { const int st = (r >> 4) * 2 + (c >> 5), rr = r & 15, cc = c & 31, ob = rr * 64 + cc * 2; return st * 1024 + (ob ^ (((ob >> 9) & 1) << 5)); }
__host__ __device__ __forceinline__ void stage_rc(int b, int& R, int& C) { const int st = b / 1024, sb = b % 1024, swz = sb ^ (((sb >> 9) & 1) << 5); R = (st >> 1) * 16 + swz / 64; C = (st & 1) * 32 + (swz % 64) / 2; }
__host__ __device__ __forceinline__ int perm32(int rho) { const int n = rho >> 4, i = rho & 15; return 8 * (i >> 2) + 4 * n + (i & 3); }

struct Unit { int pm, pn, pg, kt0, nt; };
struct Gemm { const bf16_t* A; const bf16_t* Bt; int K, lda, ldb; size_t gsA, gsB; };

struct StaticOrder {
    int nM, nN, nwg, G, c;
    __device__ __forceinline__ void init(int M, int N, int G_, int c_) { nM = M / BM; nN = N / BM; nwg = nM * nN; G = G_; c = c_; }
    __device__ __forceinline__ bool next(int i, Unit& u) const {
        const long L = (long)i * G + c; if (L >= nwg) return false;
        int wgid = (int)L; { const int q = nwg / NXCD, r = nwg % NXCD, xcd = wgid % NXCD, off = wgid / NXCD; wgid = (xcd < r ? xcd * (q + 1) : r * (q + 1) + (xcd - r) * q) + off; }
        const int nig = WGM * nN, gid = wgid / nig, fm = gid * WGM, gsz = (nM - fm) < WGM ? (nM - fm) : WGM;
        u.pm = fm + ((wgid % nig) % gsz); u.pn = (wgid % nig) / gsz; u.pg = 0; u.kt0 = 0; u.nt = 0; return true;
    }
};
struct GroupOrder {
    int nM, nN, per, total, G, vc, tri;
    __device__ __forceinline__ void init(int nM_, int nN_, int ngroups, int G_, int c_, int tri_) { nM = nM_; nN = nN_; per = nM_ * nN_; total = per * ngroups; G = G_; tri = tri_; vc = (G_ % 8 == 0) ? (c_ % 8) * (G_ / 8) + c_ / 8 : c_; }
    __device__ __forceinline__ bool next(int i, Unit& u) const {
        const int L = i * G + vc; if (L >= total) return false;
        u.pg = L / per; const int r = L % per; u.pm = r / nN; u.pn = r % nN; u.kt0 = 0; u.nt = 0;
        if (tri) { const int p = u.pn, rr = i % 3; u.pn = rr == 0 ? p : (rr == 1 ? ((p + 2) & 3) : ((0x1203 >> (4 * p)) & 3)); u.nt = 2 + 4 * (u.pn + 1); }
        return true;
    }
};

struct PanelOrder {
    int nN, total, G, vc;
    __device__ __forceinline__ void init(int M, int N, int G_, int c_) { nN = N / BM; total = (M / BM) * nN; G = G_; vc = (G_ % 8 == 0) ? (c_ % 8) * (G_ / 8) + c_ / 8 : c_; }
    __device__ __forceinline__ bool next(int i, Unit& u) const {
        const int L = i * G + vc; if (L >= total) return false;
        u.pg = 0; u.pm = L / nN; u.pn = L % nN; u.kt0 = 0; u.nt = 0; return true;
    }
};
struct PrefixOrder {
    StaticOrder base; int has, pm, pn;
    __device__ __forceinline__ bool next(int i, Unit& u) const {
        if (has) { if (i == 0) { u.pm = pm; u.pn = pn; u.pg = 0; u.kt0 = 0; u.nt = 0; return true; } return base.next(i - 1, u); }
        return base.next(i, u);
    }
};
struct OneUnit { int pm, pn; __device__ __forceinline__ bool next(int i, Unit& u) const { if (i > 0) return false; u.pm = pm; u.pn = pn; u.pg = 0; u.kt0 = 0; u.nt = 0; return true; } };
template <class Epi, class Sched>
__device__ __forceinline__ void gemm_phase(LAS unsigned char* lds, const Gemm g_in, const Sched& S, const Epi& E, int wave_s) {
    Gemm g = g_in;
    int tid = wave_s * 64 + my_lane();
    asm volatile("" : "+v"(tid));
    asm volatile("" : "+s"(g.K), "+s"(g.lda), "+s"(g.ldb));
    asm volatile("" : "+s"(g.A), "+s"(g.Bt));
    const int wid = __builtin_amdgcn_readfirstlane(tid >> 6), lane = tid & 63, wr = wid >> 2, wc = wid & 3, fr = lane & 15, fq = lane >> 4;
    const int K = g.K, nt_all = K / BK;
    unsigned voffA, voffB;
    { int R, C; stage_rc(tid * 16, R, C); const int Rb = ((R & ~31) + perm32(R & 31)); voffA = (unsigned)(R * g.lda + C) * 2u; voffB = (unsigned)(Rb * g.ldb + C) * 2u; }
    const size_t kstep = (size_t)(BK * 2);
    const size_t hstepA = (size_t)HALF * g.lda * 2, hstepB = (size_t)HALF * g.ldb * 2;
    const size_t tstepA = 2 * hstepA, tstepB = 2 * hstepB, qvoffA = hstepA / 2, qvoffB = hstepB / 2;
    const unsigned ldsw = (unsigned)wid * 1024u;
    const int aoff = lds_byte(wr * 64 + fr, fq * 8), boff = lds_byte(wc * 32 + fr, fq * 8);
#define PG8_SA(b, h) (((b) * 2 + (h)) * HTB)
#define PG8_SB(b, h) ((4 + (b) * 2 + (h)) * HTB)
#define PG8_STAGE(bufoff, gbase, voff) do { \
        __builtin_amdgcn_global_load_lds((const unsigned*)((const char*)(gbase) + (voff)), (LAS unsigned*)(lds + (bufoff) + ldsw), 16, 0, 0); \
        __builtin_amdgcn_global_load_lds((const unsigned*)((const char*)(gbase) + q##voff + (voff)), (LAS unsigned*)(lds + (bufoff) + ldsw + 8192), 16, 0, 0); } while (0)
#define PG8_LDA(dst, b, h) do { _Pragma("unroll") for (int m = 0; m < 4; ++m) _Pragma("unroll") for (int k = 0; k < 2; ++k) dst[m][k] = *(const LAS bf16x8*)(lds + PG8_SA(b, h) + aoff + m * 2048 + k * 1024); } while (0)
#define PG8_LDB(dst, b, h) do { _Pragma("unroll") for (int n = 0; n < 2; ++n) _Pragma("unroll") for (int k = 0; k < 2; ++k) dst[n][k] = *(const LAS bf16x8*)(lds + PG8_SB(b, h) + boff + n * 2048 + k * 1024); } while (0)
#define PG8_MMA(ai, bj, At, Bt) do { __builtin_amdgcn_s_setprio(1); _Pragma("unroll") for (int m = 0; m < 4; ++m) _Pragma("unroll") for (int n = 0; n < 2; ++n) _Pragma("unroll") for (int k = 0; k < 2; ++k) \
        acc[ai][bj][m][n] = __builtin_amdgcn_mfma_f32_16x16x32_bf16(Bt[n][k], At[m][k], acc[ai][bj][m][n], 0, 0, 0); __builtin_amdgcn_s_setprio(0); } while (0)
#define PG8_WAIT_V(n) asm volatile("s_waitcnt vmcnt(" #n ")" ::: "memory")
#define PG8_WAIT_L(n) asm volatile("s_waitcnt lgkmcnt(" #n ")" ::: "memory")
#define PG8_BAR __builtin_amdgcn_s_barrier()
#define PG8_SCHED __builtin_amdgcn_sched_barrier(0)
    Unit cur, nxt; int ui = 0;
    if (!S.next(0, cur)) return;
    if (cur.nt <= 0) cur.nt = nt_all;
    f32x4 acc[2][2][4][2];
#pragma unroll
    for (int a = 0; a < 2; ++a)
#pragma unroll
        for (int b = 0; b < 2; ++b)
#pragma unroll
            for (int m = 0; m < 4; ++m)
#pragma unroll
                for (int n = 0; n < 2; ++n) acc[a][b][m][n] = (f32x4){0.f, 0.f, 0.f, 0.f};
    bf16x8 At[4][2], B0[2][2], B1[2][2];
    const char* cA = (const char*)(g.A + (size_t)cur.pg * g.gsA) + (size_t)cur.pm * tstepA + (size_t)cur.kt0 * kstep; const char* cB = (const char*)(g.Bt + (size_t)cur.pg * g.gsB) + (size_t)cur.pn * tstepB + (size_t)cur.kt0 * kstep;
    PG8_STAGE(PG8_SB(0, 0), cB, voffB); PG8_STAGE(PG8_SB(0, 1), cB + hstepB, voffB); PG8_STAGE(PG8_SA(0, 0), cA, voffA); PG8_STAGE(PG8_SA(0, 1), cA + hstepA, voffA);
    if (wr == 1) PG8_BAR;
    PG8_WAIT_V(2); PG8_BAR;
    PG8_STAGE(PG8_SB(1, 0), cB + kstep, voffB); PG8_STAGE(PG8_SA(1, 0), cA + kstep, voffA); PG8_STAGE(PG8_SB(1, 1), cB + hstepB + kstep, voffB);
    PG8_WAIT_V(6); PG8_BAR;
    for (;;) {
        const bool has_next = S.next(ui + 1, nxt);
        if (has_next && nxt.nt <= 0) nxt.nt = nt_all;
        const int nt = cur.nt;
        const char* nA = has_next ? (const char*)(g.A + (size_t)nxt.pg * g.gsA) + (size_t)nxt.pm * tstepA + (size_t)nxt.kt0 * kstep : cA;
        const char* nB = has_next ? (const char*)(g.Bt + (size_t)nxt.pg * g.gsB) + (size_t)nxt.pn * tstepB + (size_t)nxt.kt0 * kstep : cB;
        for (int t = 0; t < nt; t += 2) {
            const bool last = (t == nt - 2);
            const char* a1 = cA + (size_t)(t + 1) * kstep;
            const char* a2 = last ? nA : cA + (size_t)(t + 2) * kstep; const char* b2 = last ? nB : cB + (size_t)(t + 2) * kstep;
            const char* a3 = a2 + kstep; const char* b3 = b2 + kstep;
            PG8_LDB(B0, 0, 0); PG8_LDB(B1, 0, 1); PG8_SCHED; PG8_LDA(At, 0, 0); PG8_STAGE(PG8_SA(1, 1), a1 + hstepA, voffA);
            PG8_WAIT_V(8); PG8_WAIT_L(0); PG8_BAR; PG8_MMA(0, 0, At, B0); PG8_MMA(0, 1, At, B1); PG8_BAR; PG8_SCHED;
            PG8_LDA(At, 0, 1); PG8_STAGE(PG8_SB(0, 0), b2, voffB); PG8_STAGE(PG8_SB(0, 1), b2 + hstepB, voffB); PG8_STAGE(PG8_SA(0, 0), a2, voffA);
            PG8_WAIT_V(8); PG8_WAIT_L(0); PG8_BAR; PG8_MMA(1, 0, At, B0); PG8_MMA(1, 1, At, B1); PG8_BAR; PG8_SCHED;
            PG8_LDB(B0, 1, 0); PG8_LDB(B1, 1, 1); PG8_SCHED; PG8_LDA(At, 1, 0); PG8_STAGE(PG8_SA(0, 1), a2 + hstepA, voffA);
            PG8_WAIT_V(8); PG8_WAIT_L(0); PG8_BAR; PG8_MMA(0, 0, At, B0); PG8_MMA(0, 1, At, B1); PG8_BAR; PG8_SCHED;
            PG8_LDA(At, 1, 1); PG8_STAGE(PG8_SB(1, 0), b3, voffB); PG8_STAGE(PG8_SB(1, 1), b3 + hstepB, voffB); PG8_STAGE(PG8_SA(1, 0), a3, voffA);
            PG8_WAIT_V(8); PG8_WAIT_L(0); PG8_BAR; PG8_MMA(1, 0, At, B0); PG8_MMA(1, 1, At, B1); PG8_BAR; PG8_SCHED;
        }
        if (wr == 0) PG8_BAR;
        E(acc, cur, wr, wc, fr, fq);
        if (!has_next) break;
#pragma unroll
        for (int a = 0; a < 2; ++a)
#pragma unroll
            for (int b = 0; b < 2; ++b)
#pragma unroll
                for (int m = 0; m < 4; ++m)
#pragma unroll
                    for (int n = 0; n < 2; ++n) acc[a][b][m][n] = (f32x4){0.f, 0.f, 0.f, 0.f};
        cur = nxt; cA = nA; cB = nB; ++ui;
        if (wr == 1) PG8_BAR;
    }
    PG8_WAIT_V(0);
    PG8_BAR;
#undef PG8_SA
#undef PG8_SB
#undef PG8_STAGE
#undef PG8_LDA
#undef PG8_LDB
#undef PG8_MMA
#undef PG8_WAIT_V
#undef PG8_WAIT_L
#undef PG8_BAR
#undef PG8_SCHED
}
}

typedef f32x4 Acc[2][2][4][2];
#define EPI_LOOP _Pragma("unroll") for (int ai = 0; ai < 2; ++ai) _Pragma("unroll") for (int m = 0; m < 4; ++m, ({ if (!(m & 1)) asm volatile("" ::: "memory"); })) _Pragma("unroll") for (int bj = 0; bj < 2; ++bj)

struct EpiQKV {
    const float* bias; const float* rope; bf16_t* Q; bf16_t* Kb; bf16_t* Vb; bf16_t* KS; bf16_t* VS; float* okp; float* ovp; float* oks; float* ovs;
    __device__ __forceinline__ void operator()(Acc& acc, const pg8::Unit& u, int wr, int wc, int fr, int fq) const {
        EPI_LOOP {
            const int row = u.pm * 256 + ai * 128 + wr * 64 + m * 16 + fr, col0 = u.pn * 256 + bj * 128 + wc * 32 + fq * 8;
            const f32x4 v0 = acc[ai][bj][m][0], v1 = acc[ai][bj][m][1];
            const bool smp = row >= MP; const int rs = row - MP;
            const int pos = smp ? 4096 + (rs & 63) : (row & 4095);
            if (col0 < 1152) {
                const int hb = col0 & ~63, i0 = (col0 & 63) >> 1;
                const f32x4 b1 = *(const f32x4*)(bias + hb + i0), b2 = *(const f32x4*)(bias + hb + 32 + i0);
                const f32x4 cs0 = *(const f32x4*)(rope + ((size_t)pos * 32 + i0) * 2), cs1 = *(const f32x4*)(rope + ((size_t)pos * 32 + i0) * 2 + 4);
                const f32x4 x1 = (f32x4){v0[0], v0[2], v1[0], v1[2]} + b1, x2 = (f32x4){v0[1], v0[3], v1[1], v1[3]} + b2;
                const f32x4 cc = (f32x4){cs0[0], cs0[2], cs1[0], cs1[2]}, ss = (f32x4){cs0[1], cs0[3], cs1[1], cs1[3]};
                f32x4 o1 = x1 * cc - x2 * ss, o2 = x2 * cc + x1 * ss;
                if (col0 < 1024) {
                    o1 = o1 * 0.18033688011112042f; o2 = o2 * 0.18033688011112042f;
                    u32x4 w; w.x = cvt_pk_bf16(o1[0], o2[0]); w.y = cvt_pk_bf16(o1[1], o2[1]); w.z = cvt_pk_bf16(o1[2], o2[2]); w.w = cvt_pk_bf16(o1[3], o2[3]);
                    *(u32x4*)(Q + (size_t)row * D + col0) = w;
                } else {
                    const int kc = col0 - 1024;
                    u32x4 w; w.x = cvt_pk_bf16(o1[0], o2[0]); w.y = cvt_pk_bf16(o1[1], o2[1]); w.z = cvt_pk_bf16(o1[2], o2[2]); w.w = cvt_pk_bf16(o1[3], o2[3]);
                    const int oc = (kc & 64) + i0;
                    if (!smp) {
                        *(u32x4*)(Kb + (size_t)row * 128 + kc) = w;
                        const int s = row & 4095;
                        if (s >= 3968) { float* o = okp + ((size_t)((row >> 12) * 128 + (s - 3968)) * 128) + oc; *(f32x4*)o = o1; *(f32x4*)(o + 32) = o2; }
                    } else {
                        const int b = rs >> 6, t = rs & 63;
                        *(u32x4*)(KS + (size_t)(b * 192 + 128 + t) * 128 + kc) = w;
                        float* o = oks + ((size_t)(b * 128 + 64 + t) * 128) + oc; *(f32x4*)o = o1; *(f32x4*)(o + 32) = o2;
                    }
                }
            } else {
                const int vc = col0 - 1152;
                const f32x4 a0 = v0 + *(const f32x4*)(bias + col0), a1 = v1 + *(const f32x4*)(bias + col0 + 4);
                u32x4 w; w.x = cvt_pk_bf16(a0[0], a0[1]); w.y = cvt_pk_bf16(a0[2], a0[3]); w.z = cvt_pk_bf16(a1[0], a1[1]); w.w = cvt_pk_bf16(a1[2], a1[3]);
                if (!smp) {
                    *(u32x4*)(Vb + (size_t)row * 128 + vc) = w;
                    const int s = row & 4095;
                    if (s >= 3968) { float* o = ovp + ((size_t)((row >> 12) * 128 + (s - 3968)) * 128) + vc; *(f32x4*)o = a0; *(f32x4*)(o + 4) = a1; }
                } else {
                    const int b = rs >> 6, t = rs & 63;
                    *(u32x4*)(VS + (size_t)(b * 192 + 128 + t) * 128 + vc) = w;
                    float* o = ovs + ((size_t)(b * 128 + 64 + t) * 128) + vc; *(f32x4*)o = a0; *(f32x4*)(o + 4) = a1;
                }
            }
        }
    }
};
struct EpiResid {
    const float* xp; const float* xs; const float* bias; float* Z;
    __device__ __forceinline__ void operator()(Acc& acc, const pg8::Unit& u, int wr, int wc, int fr, int fq) const {
        EPI_LOOP {
            const int row = u.pm * 256 + ai * 128 + wr * 64 + m * 16 + fr, col0 = u.pn * 256 + bj * 128 + wc * 32 + fq * 8;
            const float* xr = (row < MP ? xp + (size_t)row * D : xs + (size_t)(row - MP) * D) + col0;
            f32x4 a0 = acc[ai][bj][m][0], a1 = acc[ai][bj][m][1];
            if (bias) { a0 += *(const f32x4*)(bias + col0); a1 += *(const f32x4*)(bias + col0 + 4); }
            const f32x4 x0 = *(const f32x4*)xr, x1 = *(const f32x4*)(xr + 4);
            float* z = Z + (size_t)row * D + col0;
            *(f32x4*)z = x0 * ALPHA + a0; *(f32x4*)(z + 4) = x1 * ALPHA + a1;
        }
    }
};
__device__ __forceinline__ float silu_mul(float g, float u) { return g * u * __builtin_amdgcn_rcpf(1.f + __expf(-g)); }
__device__ __forceinline__ unsigned silu_mul2_pk(float g0, float u0, float g1, float u1) {
    const float e0 = __builtin_amdgcn_exp2f(fminf(-1.4426950408889634f * g0, 43.f)), e1 = __builtin_amdgcn_exp2f(fminf(-1.4426950408889634f * g1, 43.f));
    const float d0 = 1.f + e0, d1 = 1.f + e1, r = __builtin_amdgcn_rcpf(d0 * d1);
    return cvt_pk_bf16((g0 * u0) * (r * d1), (g1 * u1) * (r * d0));
}
struct EpiSwiGLU {
    bf16_t* H; unsigned* pub;
    __device__ __forceinline__ void operator()(Acc& acc, const pg8::Unit& u, int wr, int wc, int fr, int fq) const {
        body(acc, u, wr, wc, fr, fq);
        if (pub && u.pm >= 128) {
            asm volatile("s_waitcnt vmcnt(0)" ::: "memory"); __builtin_amdgcn_s_barrier(); asm volatile("" ::: "memory");
            if (wr == 0 && wc == 0) { __builtin_amdgcn_fence(__ATOMIC_RELEASE, "agent"); asm volatile("s_waitcnt vmcnt(0)" ::: "memory");
                                      if (fr == 0 && fq == 0) __hip_atomic_fetch_add(pub, 1u, __ATOMIC_RELAXED, __HIP_MEMORY_SCOPE_AGENT); }
        }
    }
    __device__ __forceinline__ void body(Acc& acc, const pg8::Unit& u, int wr, int wc, int fr, int fq) const {
        const int hcol = u.pn * 128 + wc * 32 + fq * 8;
#pragma unroll
        for (int ai = 0; ai < 2; ++ai)
#pragma unroll
            for (int m = 0; m < 4; ++m) {
                const int row = u.pm * 256 + ai * 128 + wr * 64 + m * 16 + fr;
                const f32x4 a0 = acc[ai][0][m][0], a1 = acc[ai][0][m][1], b0 = acc[ai][1][m][0], b1 = acc[ai][1][m][1];
                u32x4 w; w.x = silu_mul2_pk(a0[0], a0[1], a0[2], a0[3]); w.y = silu_mul2_pk(a1[0], a1[1], a1[2], a1[3]);
                w.z = silu_mul2_pk(b0[0], b0[1], b0[2], b0[3]); w.w = silu_mul2_pk(b1[0], b1[1], b1[2], b1[3]);
                *(u32x4*)(H + (size_t)row * DFF + hcol) = w;
            }
    }
};
struct EpiSsmIn {
    const float* bias; bf16_t* U;
    __device__ __forceinline__ void operator()(Acc& acc, const pg8::Unit& u, int wr, int wc, int fr, int fq) const {
        f32x4 bs[2][2];
#pragma unroll
        for (int bj = 0; bj < 2; ++bj) { const int cb = u.pn * 256 + bj * 128 + wc * 32 + fq * 8; bs[bj][0] = *(const f32x4*)(bias + cb); bs[bj][1] = *(const f32x4*)(bias + cb + 4); }
        EPI_LOOP {
            const int row = u.pm * 256 + ai * 128 + wr * 64 + m * 16 + fr, col0 = u.pn * 256 + bj * 128 + wc * 32 + fq * 8;
            const f32x4 a0 = acc[ai][bj][m][0] + bs[bj][0], a1 = acc[ai][bj][m][1] + bs[bj][1];
            u32x4 w; w.x = cvt_pk_bf16(a0[0], a0[1]); w.y = cvt_pk_bf16(a0[2], a0[3]); w.z = cvt_pk_bf16(a1[0], a1[1]); w.w = cvt_pk_bf16(a1[2], a1[3]);
            const int g = col0 >> 4, bc = row >> 6, j = row & 63;
            *(u32x4*)(U + ((size_t)(g * NBC + bc) * KT) + 128 + j * 16 + (col0 & 15)) = w;
        }
    }
};
struct EpiDS {
    float* DS;
    __device__ __forceinline__ void operator()(Acc& acc, const pg8::Unit& u, int wr, int wc, int fr, int fq) const {
#pragma unroll
        for (int ai = 0; ai < 2; ++ai)
#pragma unroll
            for (int m = 0; m < 4; ++m) {
                const int bc = u.pm * 256 + ai * 128 + wr * 64 + m * 16 + fr, col0 = wc * 32 + fq * 8;
                if (bc < NBC) { float* o = DS + ((size_t)(u.pg * NBC + bc) * 128) + col0; *(f32x4*)o = acc[ai][0][m][0]; *(f32x4*)(o + 4) = acc[ai][0][m][1]; }
            }
    }
};
__device__ __forceinline__ float gelu_tanh(float y) { const float t = 0.7978845608028654f * (y + 0.044715f * y * y * y); return y * __builtin_amdgcn_rcpf(1.f + __expf(-2.f * t)); }
struct EpiToep {
    const bf16_t* U; const float* dvec; bf16_t* ZG;
    __device__ __forceinline__ void operator()(Acc& acc, const pg8::Unit& u, int wr, int wc, int fr, int fq) const {
        const int bcb = u.pm * 256 + wr * 64 + fr, nb = u.pn * 256 + wc * 32 + fq * 8, c0 = nb & 15, ch = u.pg * 16 + c0;
        const f32x4 d0 = *(const f32x4*)(dvec + ch), d1 = *(const f32x4*)(dvec + ch + 4);
        u32x4 uw[2][4][2];
#pragma unroll
        for (int ai = 0; ai < 2; ++ai)
#pragma unroll
            for (int m = 0; m < 4; ++m)
#pragma unroll
                for (int bj = 0; bj < 2; ++bj) { const int bc = bcb + ai * 128 + m * 16; uw[ai][m][bj] = (u32x4){0u, 0u, 0u, 0u};
                    if (bc < NBC) uw[ai][m][bj] = *(const u32x4*)(U + ((size_t)(u.pg * NBC + bc) * KT) + 128 + nb + bj * 128); }
        EPI_LOOP {
            const int bc = bcb + ai * 128 + m * 16, n0 = nb + bj * 128;
            if (bc < NBC) {
                const int t = n0 >> 4;
                const u32x4 w_ = uw[ai][m][bj];
                const f32x4 v0 = acc[ai][bj][m][0], v1 = acc[ai][bj][m][1];
                const float y0 = v0[0] + d0[0] * bflo(w_.x), y1 = v0[1] + d0[1] * bfhi(w_.x), y2 = v0[2] + d0[2] * bflo(w_.y), y3 = v0[3] + d0[3] * bfhi(w_.y);
                const float y4 = v1[0] + d1[0] * bflo(w_.z), y5 = v1[1] + d1[1] * bfhi(w_.z), y6 = v1[2] + d1[2] * bflo(w_.w), y7 = v1[3] + d1[3] * bfhi(w_.w);
                u32x4 w; w.x = cvt_pk_bf16(gelu_tanh(y0), gelu_tanh(y1)); w.y = cvt_pk_bf16(gelu_tanh(y2), gelu_tanh(y3));
                w.z = cvt_pk_bf16(gelu_tanh(y4), gelu_tanh(y5)); w.w = cvt_pk_bf16(gelu_tanh(y6), gelu_tanh(y7));
                *(u32x4*)(ZG + (size_t)(bc * 64 + t) * D + ch) = w;
            }
        }
    }
};
struct EpiGLU {
    const float* bias; const float* X; float* Z;
    __device__ __forceinline__ void operator()(Acc& acc, const pg8::Unit& u, int wr, int wc, int fr, int fq) const {
        EPI_LOOP {
            const int row = u.pm * 256 + ai * 128 + wr * 64 + m * 16 + fr, col0 = u.pn * 256 + bj * 128 + wc * 32 + fq * 8, oc = col0 >> 1;
            const f32x4 v0 = acc[ai][bj][m][0], v1 = acc[ai][bj][m][1];
            const f32x4 bv = *(const f32x4*)(bias + oc), bg = *(const f32x4*)(bias + D + oc);
            const f32x4 x = *(const f32x4*)(X + (size_t)row * D + oc);
            f32x4 o;
            o[0] = (v0[0] + bv[0]) * __builtin_amdgcn_rcpf(1.f + __expf(-(v0[1] + bg[0])));
            o[1] = (v0[2] + bv[1]) * __builtin_amdgcn_rcpf(1.f + __expf(-(v0[3] + bg[1])));
            o[2] = (v1[0] + bv[2]) * __builtin_amdgcn_rcpf(1.f + __expf(-(v1[1] + bg[2])));
            o[3] = (v1[2] + bv[3]) * __builtin_amdgcn_rcpf(1.f + __expf(-(v1[3] + bg[3])));
            *(f32x4*)(Z + (size_t)row * D + oc) = x * ALPHA + o;
        }
    }
};


constexpr size_t WS_XBUF = 506 * MiB, WS_CNT = 509 * MiB;
constexpr size_t WS_END2 = 510 * MiB;
struct LnX { unsigned long long* xbuf; unsigned tag; const float* gain; const float* beta; LAS unsigned char* lx; };
template <int NV>
__device__ __forceinline__ void panel_ln_stats(const Acc& v, int pm, int pn, int ntn, const LnX& L, int wr, int wc, int fr, int fq) {
    LAS f32x2* P = (LAS f32x2*)L.lx;
    LAS f32x2* S = (LAS f32x2*)(L.lx + 8192);
    const int wid = wr * 4 + wc, lane = fq * 16 + fr;
    constexpr float NW = 32.f * NV;
#pragma unroll
    for (int ai = 0; ai < 2; ++ai)
#pragma unroll
        for (int m = 0; m < 4; ++m) {
            float s = 0.f;
#pragma unroll
            for (int bj = 0; bj < 2; ++bj)
#pragma unroll
                for (int n = 0; n < NV; ++n) { const f32x4 x = v[ai][bj][m][n]; s += (x[0] + x[1]) + (x[2] + x[3]); }
            s += __shfl_xor(s, 16); s += __shfl_xor(s, 32);
            const float mw = s * (1.0f / NW); float q = 0.f;
#pragma unroll
            for (int bj = 0; bj < 2; ++bj)
#pragma unroll
                for (int n = 0; n < NV; ++n) { const f32x4 d = v[ai][bj][m][n] - mw; q += (d[0] * d[0] + d[1] * d[1]) + (d[2] * d[2] + d[3] * d[3]); }
            q += __shfl_xor(q, 16); q += __shfl_xor(q, 32);
            if (fq == 0) P[(ai * 128 + wr * 64 + m * 16 + fr) * 4 + wc] = (f32x2){mw, q};
        }
    asm volatile("s_waitcnt lgkmcnt(0)" ::: "memory"); __builtin_amdgcn_s_barrier(); asm volatile("" ::: "memory");
    const int row = wid * 32 + (lane & 31);
    unsigned long long* slots = L.xbuf + ((size_t)(pm * 256 + row) * 8);
    const unsigned tag = L.tag;
    if (lane < 32) {
        const f32x2 a = P[row * 4 + 0], b = P[row * 4 + 1], c = P[row * 4 + 2], d = P[row * 4 + 3];
        const float mt = (a.x + b.x + c.x + d.x) * 0.25f;
        const float da = a.x - mt, db = b.x - mt, dc = c.x - mt, dd = d.x - mt;
        const float m2 = (a.y + b.y) + (c.y + d.y) + NW * ((da * da + db * db) + (dc * dc + dd * dd));
        const unsigned m2b = (__float_as_uint(m2) & ~15u) | tag;
        __hip_atomic_store(slots + pn, ((unsigned long long)m2b << 32) | __float_as_uint(mt), __ATOMIC_RELAXED, __HIP_MEMORY_SCOPE_AGENT);
    }
    {
        float mt[8], m2[8]; unsigned sp = 0;
        for (;;) {
            int bad = 0;
            if (lane < 32) {
#pragma unroll
                for (int t = 0; t < 8; ++t) {
                    if (t < ntn) { const unsigned long long w = __hip_atomic_load(slots + t, __ATOMIC_RELAXED, __HIP_MEMORY_SCOPE_AGENT); const unsigned hi = (unsigned)(w >> 32);
                                   bad |= ((hi & 15u) != tag) ? 1 : 0; mt[t] = __uint_as_float((unsigned)w); m2[t] = __uint_as_float(hi & ~15u); }
                    else { mt[t] = 0.f; m2[t] = 0.f; }
                }
            }
            if (!__any(bad) || ++sp > (1u << 18)) break;
            __builtin_amdgcn_s_sleep(1);
        }
        if (lane < 32) {
            float ms = 0.f;
#pragma unroll
            for (int t = 0; t < 8; ++t) ms += mt[t];
            const float mean = ms / (float)ntn; float q = 0.f;
#pragma unroll
            for (int t = 0; t < 8; ++t) if (t < ntn) { const float dm = mt[t] - mean; q += m2[t] + (4.f * NW) * dm * dm; }
            S[row] = (f32x2){mean, 1.0f / sqrtf(q / (4.f * NW * (float)ntn) + LN_EPS)};
        }
    }
    asm volatile("s_waitcnt lgkmcnt(0)" ::: "memory"); __builtin_amdgcn_s_barrier(); asm volatile("" ::: "memory");
}
#define EPI_LOOP_NF _Pragma("unroll") for (int ai = 0; ai < 2; ++ai) _Pragma("unroll") for (int m = 0; m < 4; ++m) _Pragma("unroll") for (int bj = 0; bj < 2; ++bj)
template <bool FIN> struct EpiResidLN {
    const float* bias; float* Y; bf16_t* XN; LnX L;
    __device__ __forceinline__ void operator()(Acc& acc, const pg8::Unit& u, int wr, int wc, int fr, int fq) const {
        const int rowb = u.pm * 256 + wr * 64 + fr, colb = u.pn * 256 + wc * 32 + fq * 8;
        u32x4 xw[2][4][2];
        EPI_LOOP_NF xw[ai][m][bj] = *(const u32x4*)(XN + (size_t)(rowb + ai * 128 + m * 16) * D + colb + bj * 128);
        f32x4 bs[2][2];
#pragma unroll
        for (int bj = 0; bj < 2; ++bj) { bs[bj][0] = bias ? *(const f32x4*)(bias + colb + bj * 128) : (f32x4){0.f, 0.f, 0.f, 0.f}; bs[bj][1] = bias ? *(const f32x4*)(bias + colb + bj * 128 + 4) : (f32x4){0.f, 0.f, 0.f, 0.f}; }
        EPI_LOOP_NF {
            const u32x4 w = xw[ai][m][bj];
            acc[ai][bj][m][0] = (f32x4){bflo(w.x), bfhi(w.x), bflo(w.y), bfhi(w.y)} * ALPHA + (acc[ai][bj][m][0] + bs[bj][0]);
            acc[ai][bj][m][1] = (f32x4){bflo(w.z), bfhi(w.z), bflo(w.w), bfhi(w.w)} * ALPHA + (acc[ai][bj][m][1] + bs[bj][1]);
            asm volatile("" : "+v"(acc[ai][bj][m][0]), "+v"(acc[ai][bj][m][1]));
        }
        asm volatile("" ::: "memory");
        f32x4 gb[2][4];
#pragma unroll
        for (int bj = 0; bj < 2; ++bj) { gb[bj][0] = *(const f32x4*)(L.gain + colb + bj * 128); gb[bj][1] = *(const f32x4*)(L.gain + colb + bj * 128 + 4);
                                         gb[bj][2] = *(const f32x4*)(L.beta + colb + bj * 128); gb[bj][3] = *(const f32x4*)(L.beta + colb + bj * 128 + 4); }
        panel_ln_stats<2>(acc, u.pm, u.pn, 4, L, wr, wc, fr, fq);
        const LAS f32x2* S = (const LAS f32x2*)(L.lx + 8192);
        EPI_LOOP {
            const int r = ai * 128 + wr * 64 + m * 16 + fr, row = u.pm * 256 + r, col0 = colb + bj * 128;
            const f32x2 sr = S[r];
            const f32x4 y0 = (acc[ai][bj][m][0] - sr.x) * sr.y * gb[bj][0] + gb[bj][2], y1 = (acc[ai][bj][m][1] - sr.x) * sr.y * gb[bj][1] + gb[bj][3];
            if (FIN) { float* xo = Y + (size_t)row * D + col0; *(f32x4*)xo = y0; *(f32x4*)(xo + 4) = y1; }
            else { u32x4 w; w.x = cvt_pk_bf16(y0[0], y0[1]); w.y = cvt_pk_bf16(y0[2], y0[3]); w.z = cvt_pk_bf16(y1[0], y1[1]); w.w = cvt_pk_bf16(y1[2], y1[3]);
                   *(u32x4*)(XN + (size_t)row * D + col0) = w; }
        }
    }
};
struct EpiGLULN {
    const float* bias; bf16_t* XN; LnX L;
    __device__ __forceinline__ void operator()(Acc& acc, const pg8::Unit& u, int wr, int wc, int fr, int fq) const {
        const int rowb = u.pm * 256 + wr * 64 + fr, ocb = u.pn * 128 + wc * 32 + fq * 8;
        u32x4 xw[2][4];
#pragma unroll
        for (int ai = 0; ai < 2; ++ai)
#pragma unroll
            for (int m = 0; m < 4; ++m) xw[ai][m] = *(const u32x4*)(XN + (size_t)(rowb + ai * 128 + m * 16) * D + ocb);
        f32x4 bvg[2][2];
#pragma unroll
        for (int bj = 0; bj < 2; ++bj) { bvg[bj][0] = *(const f32x4*)(bias + ocb + 4 * bj); bvg[bj][1] = *(const f32x4*)(bias + D + ocb + 4 * bj); }
        EPI_LOOP_NF {
            const f32x4 v0 = acc[ai][bj][m][0], v1 = acc[ai][bj][m][1];
            const f32x4 bv = bvg[bj][0], bg = bvg[bj][1];
            const unsigned wlo = bj ? xw[ai][m].z : xw[ai][m].x, whi = bj ? xw[ai][m].w : xw[ai][m].y;
            const f32x4 x = (f32x4){bflo(wlo), bfhi(wlo), bflo(whi), bfhi(whi)};
            f32x4 o;
            o[0] = (v0[0] + bv[0]) * __builtin_amdgcn_rcpf(1.f + __expf(-(v0[1] + bg[0])));
            o[1] = (v0[2] + bv[1]) * __builtin_amdgcn_rcpf(1.f + __expf(-(v0[3] + bg[1])));
            o[2] = (v1[0] + bv[2]) * __builtin_amdgcn_rcpf(1.f + __expf(-(v1[1] + bg[2])));
            o[3] = (v1[2] + bv[3]) * __builtin_amdgcn_rcpf(1.f + __expf(-(v1[3] + bg[3])));
            acc[ai][bj][m][0] = x * ALPHA + o;
            asm volatile("" : "+v"(acc[ai][bj][m][0]));
        }
        asm volatile("" ::: "memory");
        f32x4 gb[2][2];
#pragma unroll
        for (int bj = 0; bj < 2; ++bj) { gb[bj][0] = *(const f32x4*)(L.gain + ocb + 4 * bj); gb[bj][1] = *(const f32x4*)(L.beta + ocb + 4 * bj); }
        panel_ln_stats<1>(acc, u.pm, u.pn, 8, L, wr, wc, fr, fq);
        const LAS f32x2* S = (const LAS f32x2*)(L.lx + 8192);
#pragma unroll
        for (int ai = 0; ai < 2; ++ai)
#pragma unroll
            for (int m = 0; m < 4; ++m) {
                const int r = ai * 128 + wr * 64 + m * 16 + fr, row = u.pm * 256 + r;
                const f32x2 sr = S[r];
                const f32x4 y0 = (acc[ai][0][m][0] - sr.x) * sr.y * gb[0][0] + gb[0][1], y1 = (acc[ai][1][m][0] - sr.x) * sr.y * gb[1][0] + gb[1][1];
                u32x4 w; w.x = cvt_pk_bf16(y0[0], y0[1]); w.y = cvt_pk_bf16(y0[2], y0[3]); w.z = cvt_pk_bf16(y1[0], y1[1]); w.w = cvt_pk_bf16(y1[2], y1[3]);
                *(u32x4*)(XN + (size_t)row * D + ocb) = w;
            }
    }
};

__device__ __forceinline__ float wave_sum(float v) {
#pragma unroll
    for (int o = 1; o < 64; o <<= 1) v += __shfl_xor(v, o);
    return v;
}
__device__ __forceinline__ int perm_col(int n, int mode, int N) {
    if (mode == 1) { if (n >= 1152) return n; const int h = n >> 6, i = n & 63; return (h << 6) + (i < 32 ? 2 * i : 2 * (i - 32) + 1); }
    if (mode == 2) { const int half = N >> 1; return n < half ? 2 * n : 2 * (n - half) + 1; }
    if (mode == 3) {
        const int half = N >> 1, which = n < half ? 0 : 1, h = n - which * half;
        const int pn = h >> 7, r = h & 127, wc = r >> 5, fq = (r >> 3) & 3, bj = (r >> 2) & 1, jj = r & 3;
        return 256 * pn + 128 * bj + 32 * wc + 8 * fq + 2 * jj + which;
    }
    return n;
}
__device__ __forceinline__ void transpose_item(const float* W, int K, int N, bf16_t* WT, int mode, LAS float* scr, int item, int lane) {
    const int nblk = N / 32, kb = item / nblk, nb = item % nblk, k0 = 64 * kb, n0 = 32 * nb;
    float tmp[32];
#pragma unroll
    for (int i = 0; i < 32; ++i) tmp[i] = __builtin_nontemporal_load(W + (size_t)(k0 + 2 * i + (lane >> 5)) * N + n0 + (lane & 31));
#pragma unroll
    for (int i = 0; i < 32; ++i) scr[(2 * i + (lane >> 5)) * 33 + (lane & 31)] = tmp[i];
    asm volatile("s_waitcnt lgkmcnt(0)" ::: "memory");
    const int c = lane & 7;
#pragma unroll
    for (int j = 0; j < 4; ++j) { const int n = (lane >> 3) + 8 * j; const LAS float* s = scr + (8 * c) * 33 + n;
        u32x4 o; o.x = cvt_pk_bf16(s[0 * 33], s[1 * 33]); o.y = cvt_pk_bf16(s[2 * 33], s[3 * 33]); o.z = cvt_pk_bf16(s[4 * 33], s[5 * 33]); o.w = cvt_pk_bf16(s[6 * 33], s[7 * 33]);
        *(u32x4*)(WT + (size_t)perm_col(n0 + n, mode, N) * K + k0 + 8 * c) = o; }
    asm volatile("s_waitcnt lgkmcnt(0)" ::: "memory");
}
struct TItem { const float* W; bf16_t* WT; int K, N, mode, item; };
__device__ __forceinline__ void transpose_load(const TItem& t, int lane, float (&tmp)[32]) {
    const int nblk = t.N / 32, kb = t.item / nblk, nb = t.item % nblk, k0 = 64 * kb, n0 = 32 * nb;
#pragma unroll
    for (int i = 0; i < 32; ++i) tmp[i] = __builtin_nontemporal_load(t.W + (size_t)(k0 + 2 * i + (lane >> 5)) * t.N + n0 + (lane & 31));
}
__device__ __forceinline__ void transpose_finish(const TItem& t, LAS float* scr, int lane, const float (&tmp)[32]) {
    const int nblk = t.N / 32, kb = t.item / nblk, nb = t.item % nblk, k0 = 64 * kb, n0 = 32 * nb;
#pragma unroll
    for (int i = 0; i < 32; ++i) scr[(2 * i + (lane >> 5)) * 33 + (lane & 31)] = tmp[i];
    asm volatile("s_waitcnt lgkmcnt(0)" ::: "memory");
    const int c = lane & 7;
#pragma unroll
    for (int j = 0; j < 4; ++j) { const int n = (lane >> 3) + 8 * j; const LAS float* sp = scr + (8 * c) * 33 + n;
        u32x4 o; o.x = cvt_pk_bf16(sp[0 * 33], sp[1 * 33]); o.y = cvt_pk_bf16(sp[2 * 33], sp[3 * 33]); o.z = cvt_pk_bf16(sp[4 * 33], sp[5 * 33]); o.w = cvt_pk_bf16(sp[6 * 33], sp[7 * 33]);
        *(u32x4*)(t.WT + (size_t)perm_col(n0 + n, t.mode, t.N) * t.K + k0 + 8 * c) = o; }
    asm volatile("s_waitcnt lgkmcnt(0)" ::: "memory");
}
__device__ __forceinline__ void cis_red(double ang, float& c, float& s) {
    const double k = rint(ang * 0.15915494309189535); const float r = (float)(ang - k * 6.283185307179586);
    c = cosf(r); s = sinf(r);
}

struct Args { const float* in[N_IN]; float* out; unsigned char* ws; int ph_lo, ph_hi; };

__device__ __forceinline__ void prologue(const Args& a, LAS unsigned char* lds, int G, int bid, int wave_s) {
    int tid = wave_s * 64 + my_lane(); asm volatile("" : "+v"(tid));
    const int lane = tid & 63, wave = tid >> 6;
    const int gw = bid * 8 + wave, NGW = G * 8;
    unsigned char* ws = a.ws;
    LAS float* scr = (LAS float*)(lds + wave * 16384);
    constexpr int C_QKV = 16 * 40, C_WO = 16 * 32, C_GLU = 16 * 64, C_UP = 16 * 176, C_DN = 44 * 32;
    constexpr int NITEMS = 2 * C_QKV + 4 * C_WO + 2 * C_GLU + 4 * C_UP + 4 * C_DN;
#define TITEM_DECODE(T_, idx_) do { int r = (idx_); \
        if (r < 2 * C_QKV) { const int l = r / C_QKV; T_ = TItem{a.in[I_WQKV] + (size_t)l * D * NQKV, (bf16_t*)(ws + WS_WQKV) + (size_t)l * NQKV * D, D, NQKV, 1, r % C_QKV}; break; } r -= 2 * C_QKV; \
        if (r < 2 * C_WO) { const int l = r / C_WO; T_ = TItem{a.in[I_WO] + (size_t)l * D * D, (bf16_t*)(ws + WS_WO) + (size_t)l * D * D, D, D, 0, r % C_WO}; break; } r -= 2 * C_WO; \
        if (r < 2 * C_WO) { const int l = r / C_WO; T_ = TItem{a.in[I_WIN] + (size_t)l * D * D, (bf16_t*)(ws + WS_WIN) + (size_t)l * D * D, D, D, 0, r % C_WO}; break; } r -= 2 * C_WO; \
        if (r < 2 * C_GLU) { const int l = r / C_GLU; T_ = TItem{a.in[I_WGLU] + (size_t)l * D * 2 * D, (bf16_t*)(ws + WS_WGLU) + (size_t)l * 2 * D * D, D, 2 * D, 3, r % C_GLU}; break; } r -= 2 * C_GLU; \
        if (r < 4 * C_UP) { const int l = r / C_UP; T_ = TItem{a.in[I_WUP] + (size_t)l * D * NUP, (bf16_t*)(ws + WS_WUP) + (size_t)l * NUP * D, D, NUP, 3, r % C_UP}; break; } r -= 4 * C_UP; \
        { const int l = r / C_DN; T_ = TItem{a.in[I_WDN] + (size_t)l * DFF * D, (bf16_t*)(ws + WS_WDN) + (size_t)l * D * DFF, DFF, D, 0, r % C_DN}; } } while (0)
    for (int it = gw; it < NITEMS; it += 2 * NGW) {
        const bool has2 = it + NGW < NITEMS;
        TItem ta, tb; TITEM_DECODE(ta, it); TITEM_DECODE(tb, has2 ? it + NGW : it);
        float tma[32], tmb[32];
        transpose_load(ta, lane, tma);
        if (has2) transpose_load(tb, lane, tmb);
        transpose_finish(ta, scr, lane, tma);
        if (has2) transpose_finish(tb, scr, lane, tmb);
    }
#undef TITEM_DECODE
    bf16_t* XN = (bf16_t*)(ws + WS_XN);
    for (int row = gw; row < MT; row += 2 * NGW) {
        const int row2 = row + NGW; const bool has2 = row2 < MT;
        const float* xr = row < MP ? a.in[I_XP] + (size_t)row * D : a.in[I_XS] + (size_t)(row - MP) * D;
        const float* xr2 = !has2 ? xr : (row2 < MP ? a.in[I_XP] + (size_t)row2 * D : a.in[I_XS] + (size_t)(row2 - MP) * D);
        f32x4 v[4], v2[4];
#pragma unroll
        for (int j = 0; j < 4; ++j) { v[j] = __builtin_nontemporal_load((const f32x4*)xr + lane + 64 * j); v2[j] = __builtin_nontemporal_load((const f32x4*)xr2 + lane + 64 * j); }
#pragma unroll
        for (int j = 0; j < 4; ++j) { u32x2 w; w.x = cvt_pk_bf16(v[j][0], v[j][1]); w.y = cvt_pk_bf16(v[j][2], v[j][3]); *((u32x2*)(XN + (size_t)row * D) + lane + 64 * j) = w; }
        if (has2) {
#pragma unroll
            for (int j = 0; j < 4; ++j) { u32x2 w; w.x = cvt_pk_bf16(v2[j][0], v2[j][1]); w.y = cvt_pk_bf16(v2[j][2], v2[j][3]); *((u32x2*)(XN + (size_t)row2 * D) + lane + 64 * j) = w; }
        }
    }
    const int gt = bid * 512 + tid, NGT = G * 512;
    for (int e = gt; e < 64; e += NGT) __hip_atomic_store((unsigned*)(ws + WS_CNT) + e, 0u, __ATOMIC_RELAXED, __HIP_MEMORY_SCOPE_AGENT);
    for (int e = gt; e < MT * 8; e += NGT) __hip_atomic_store((unsigned long long*)(ws + WS_XBUF) + e, 0ull, __ATOMIC_RELAXED, __HIP_MEMORY_SCOPE_AGENT);
    float* rope = (float*)(ws + WS_ROPE);
    for (int e = gt; e < 4160 * 32; e += NGT) { const int pos = e >> 5, i = e & 31; const double inv = exp(-(double)i * (9.210340371976184 / 32.0)); float c, s; cis_red((double)pos * inv, c, s); rope[2 * e] = c; rope[2 * e + 1] = s; }
    float* lamP = (float*)(ws + WS_LAMP); float* Bb = (float*)(ws + WS_BB);
    for (int e = gt; e < 2 * 64 * 64 * 65; e += NGT) {
        const int tau = e % 65, gp = e / 65, lg = gp >> 6;
        const double dt = exp((double)a.in[I_LOGDT][lg]); const double ar = a.in[I_ARE][gp], ai = a.in[I_AIM][gp];
        const float mag = (float)exp(dt * ar * tau); float c, s; cis_red(dt * ai * tau, c, s);
        lamP[2 * (size_t)e] = mag * c; lamP[2 * (size_t)e + 1] = mag * s;
    }
    for (int e = gt; e < 2 * 64 * 64 * 16; e += NGT) {
        const int gp = e >> 4, lg = gp >> 6;
        const double dt = exp((double)a.in[I_LOGDT][lg]); const double ar = a.in[I_ARE][gp], ai = a.in[I_AIM][gp];
        const double mag = exp(dt * ar); float c, s; cis_red(dt * ai, c, s);
        const double nr = mag * c - 1.0, ni = mag * s, den = ar * ar + ai * ai;
        const double fr_ = (nr * ar + ni * ai) / den, fi_ = (ni * ar - nr * ai) / den;
        const double br = a.in[I_BRE][e], bi = a.in[I_BIM][e];
        Bb[2 * (size_t)e] = (float)(fr_ * br - fi_ * bi); Bb[2 * (size_t)e + 1] = (float)(fr_ * bi + fi_ * br);
    }
    for (int e = gt; e < 2 * 8 * 128 * 128; e += NGT) {
        const int c = e & 127, r = (e >> 7) & 127, lb = e >> 14;
        const float kv = a.in[I_CK][e], vv = a.in[I_CV][e];
        const int i = c & 63, kc = (c & 64) + (i < 32 ? 2 * i : 2 * (i - 32) + 1);
        ((bf16_t*)(ws + WS_KS))[((size_t)lb * 192 + r) * 128 + kc] = (bf16_t)(cvt_pk_bf16(kv, 0.f) & 0xffffu);
        ((bf16_t*)(ws + WS_VS))[((size_t)lb * 192 + r) * 128 + c] = (bf16_t)(cvt_pk_bf16(vv, 0.f) & 0xffffu);
        if (r >= 64) { a.out[O_KSM + ((size_t)lb * 128 + (r - 64)) * 128 + c] = kv; a.out[O_VSM + ((size_t)lb * 128 + (r - 64)) * 128 + c] = vv; }
    }
}

__device__ __forceinline__ void ln_phase(float* X, bf16_t* XN, const float* gain, const float* bias, int G, int bid, int wave_s) {
    int tid = wave_s * 64 + my_lane(); asm volatile("" : "+v"(tid));
    const int lane = tid & 63, wave = tid >> 6, gw = bid * 8 + wave, NGW = G * 8;
    f32x4 gg[4], bb[4];
#pragma unroll
    for (int j = 0; j < 4; ++j) { gg[j] = *((const f32x4*)gain + lane + 64 * j); bb[j] = *((const f32x4*)bias + lane + 64 * j); }
    for (int row = gw; row < MT; row += NGW) {
        f32x4* xr = (f32x4*)(X + (size_t)row * D) + lane;
        f32x4 v[4]; float s = 0.f;
#pragma unroll
        for (int j = 0; j < 4; ++j) { v[j] = xr[64 * j]; s += (v[j][0] + v[j][1]) + (v[j][2] + v[j][3]); }
        const float mean = wave_sum(s) * (1.f / D); float s2 = 0.f;
#pragma unroll
        for (int j = 0; j < 4; ++j) { v[j] = v[j] - mean; s2 += (v[j][0] * v[j][0] + v[j][1] * v[j][1]) + (v[j][2] * v[j][2] + v[j][3] * v[j][3]); }
        const float rstd = 1.f / sqrtf(wave_sum(s2) * (1.f / D) + LN_EPS);
        u32x2* o8 = (u32x2*)(XN + (size_t)row * D) + lane;
#pragma unroll
        for (int j = 0; j < 4; ++j) { const f32x4 y = v[j] * rstd * gg[j] + bb[j]; xr[64 * j] = y; u32x2 w; w.x = cvt_pk_bf16(y[0], y[1]); w.y = cvt_pk_bf16(y[2], y[3]); o8[64 * j] = w; }
    }
}

__device__ __forceinline__ void attn_phase(LAS unsigned char* lds, const bf16_t* Q, const bf16_t* Kb, const bf16_t* Vb, const bf16_t* KS, const bf16_t* VS, bf16_t* O, const float* sinks, int G, int bid, int wave_s) {
    LAS bf16_t* Kl = (LAS bf16_t*)lds;
    LAS bf16_t* Vt = (LAS bf16_t*)(lds + 27648);
    int tid = wave_s * 64 + my_lane(); asm volatile("" : "+v"(tid));
    const int lane = tid & 63, wid = tid >> 6, fr = lane & 15, fq = lane >> 4;
    for (int u = bid; u < 1040; u += G) {
        int qrow0, kt0; const bf16_t* kbase; const bf16_t* vbase; int kvh;
        if (u < 1024) { const int b = u >> 7, c = (u >> 1) & 63; kvh = u & 1; qrow0 = b * 4096 + c * 64; kt0 = c >= 2 ? 0 : 2 - c;
            const long r0 = (long)b * 4096 + (long)(c - 2) * 64; kbase = Kb + r0 * 128 + kvh * 64; vbase = Vb + r0 * 128 + kvh * 64; }
        else { const int b = (u - 1024) >> 1; kvh = u & 1; qrow0 = MP + b * 64; kt0 = 0; kbase = KS + (size_t)b * 192 * 128 + kvh * 64; vbase = VS + (size_t)b * 192 * 128 + kvh * 64; }
        const int head = kvh * 8 + wid;
        bf16x8 qfa[4][2];
#pragma unroll
        for (int qt = 0; qt < 4; ++qt) { const size_t qoff = (size_t)(qrow0 + 16 * qt + fr) * D + head * 64; qfa[qt][0] = *(const bf16x8*)(Q + qoff + 8 * fq); qfa[qt][1] = *(const bf16x8*)(Q + qoff + 32 + 8 * fq); }
        __syncthreads();
#pragma unroll
        for (int i = 0; i < 3; ++i) {
            const int id = tid + 512 * i, row = id >> 3, pc = id & 7; const bool valid = (row >> 6) >= kt0;
            u32x4 kv = (u32x4){0u, 0u, 0u, 0u}, vv = (u32x4){0u, 0u, 0u, 0u};
            if (valid) { kv = *(const u32x4*)(kbase + (long)row * 128 + pc * 8); vv = *(const u32x4*)(vbase + (long)row * 128 + pc * 8); }
            *(LAS u32x4*)(Kl + row * 72 + pc * 8) = kv;
            LAS bf16_t* vd = Vt + (pc * 8) * 200 + row;
            vd[0 * 200] = (bf16_t)(vv.x & 0xffffu); vd[1 * 200] = (bf16_t)(vv.x >> 16); vd[2 * 200] = (bf16_t)(vv.y & 0xffffu); vd[3 * 200] = (bf16_t)(vv.y >> 16);
            vd[4 * 200] = (bf16_t)(vv.z & 0xffffu); vd[5 * 200] = (bf16_t)(vv.z >> 16); vd[6 * 200] = (bf16_t)(vv.w & 0xffffu); vd[7 * 200] = (bf16_t)(vv.w >> 16);
        }
        __syncthreads();
        const float sink = sinks[head] * 1.4426950408889634f;
#pragma unroll
        for (int qt = 0; qt < 4; ++qt) {
            const size_t qoff = (size_t)(qrow0 + 16 * qt + fr) * D + head * 64;
            bf16x8 qf[2];
            qf[0] = qfa[qt][0]; qf[1] = qfa[qt][1];
            f32x4 S[12];
#pragma unroll
            for (int kt = 0; kt < 12; ++kt) {
                S[kt] = (f32x4){0.f, 0.f, 0.f, 0.f};
#pragma unroll
                for (int ks = 0; ks < 2; ++ks) { const bf16x8 kf = *(const LAS bf16x8*)(Kl + (16 * kt + fr) * 72 + 32 * ks + 8 * fq); S[kt] = __builtin_amdgcn_mfma_f32_16x16x32_bf16(kf, qf[ks], S[kt], 0, 0, 0); }
            }
            if (kt0 > 0) {
#pragma unroll
                for (int kt = 0; kt < 8; ++kt) if (kt < 4 * kt0) S[kt] = (f32x4){-1e30f, -1e30f, -1e30f, -1e30f};
            }
            float mx = sink;
#pragma unroll
            for (int kt = 0; kt < 12; ++kt) mx = fmaxf(fmaxf(fmaxf(mx, S[kt][0]), fmaxf(S[kt][1], S[kt][2])), S[kt][3]);
            mx = fmaxf(mx, __shfl_xor(mx, 16)); mx = fmaxf(mx, __shfl_xor(mx, 32));
            float sum = 0.f;
#pragma unroll
            for (int kt = 0; kt < 12; ++kt) {
#pragma unroll
                for (int i = 0; i < 4; ++i) { const float p = __builtin_amdgcn_exp2f(S[kt][i] - mx); S[kt][i] = p; sum += p; }
            }
            sum += __shfl_xor(sum, 16); sum += __shfl_xor(sum, 32);
            sum += __builtin_amdgcn_exp2f(sink - mx);
            const float inv = 1.f / sum;
            f32x4 Oa[4];
#pragma unroll
            for (int dt = 0; dt < 4; ++dt) Oa[dt] = (f32x4){0.f, 0.f, 0.f, 0.f};
#pragma unroll
            for (int kb = 0; kb < 6; ++kb) {
                u32x4 pw; pw.x = cvt_pk_bf16(S[2 * kb][0], S[2 * kb][1]); pw.y = cvt_pk_bf16(S[2 * kb][2], S[2 * kb][3]);
                pw.z = cvt_pk_bf16(S[2 * kb + 1][0], S[2 * kb + 1][1]); pw.w = cvt_pk_bf16(S[2 * kb + 1][2], S[2 * kb + 1][3]);
                const bf16x8 pf = __builtin_bit_cast(bf16x8, pw);
#pragma unroll
                for (int dt = 0; dt < 4; ++dt) {
                    const LAS bf16_t* vp = Vt + (16 * dt + fr) * 200 + 32 * kb + 4 * fq;
                    const u32x2 lo = *(const LAS u32x2*)vp, hi = *(const LAS u32x2*)(vp + 16);
                    const u32x4 vw = (u32x4){lo.x, lo.y, hi.x, hi.y};
                    Oa[dt] = __builtin_amdgcn_mfma_f32_16x16x32_bf16(__builtin_bit_cast(bf16x8, vw), pf, Oa[dt], 0, 0, 0);
                }
            }
#pragma unroll
            for (int dt = 0; dt < 4; ++dt) { const f32x4 o = Oa[dt] * inv; u32x2 w; w.x = cvt_pk_bf16(o[0], o[1]); w.y = cvt_pk_bf16(o[2], o[3]); *(u32x2*)(O + qoff + 16 * dt + 4 * fq) = w; }
        }
    }
}

__device__ __forceinline__ void ssm_ktab(LAS unsigned char* lds, const float* cre, const float* cim, const float* lamP, const float* Bb, float* Ktab, int G, int bid, int wave_s) {
    int tid = wave_s * 64 + my_lane(); asm volatile("" : "+v"(tid));
    LAS f32x2* Cl = (LAS f32x2*)lds;
    LAS f32x2* Bl = (LAS f32x2*)(lds + 8192);
    LAS f32x2* Ll = (LAS f32x2*)(lds + 16384);
    for (int it = bid; it < 256; it += G) {
        const int g = it >> 2, t0 = (it & 3) * 16;
        __syncthreads();
        for (int e = tid; e < 1024; e += 512) {
            Cl[e] = (f32x2){cre[g * 1024 + e], cim[g * 1024 + e]};
            Bl[e] = *(const f32x2*)(Bb + ((size_t)g * 1024 + e) * 2);
            const int p = e >> 4, tt = e & 15; Ll[e] = *(const f32x2*)(lamP + ((size_t)(g * 64 + p) * 65 + t0 + tt) * 2);
        }
        __syncthreads();
        const int c = (tid >> 4) & 15, cp = tid & 15, th = tid >> 8;
        float acc[8];
#pragma unroll
        for (int r = 0; r < 8; ++r) acc[r] = 0.f;
#pragma unroll 4
        for (int p = 0; p < 64; ++p) {
            const f32x2 cc = Cl[c * 64 + p], bb = Bl[p * 16 + cp];
            const float uu = cc.x * bb.x - cc.y * bb.y, vv = cc.y * bb.x + cc.x * bb.y;
#pragma unroll
            for (int r = 0; r < 8; ++r) { const f32x2 lm = Ll[p * 16 + r * 2 + th]; acc[r] += lm.x * uu - lm.y * vv; }
        }
#pragma unroll
        for (int r = 0; r < 8; ++r) Ktab[((size_t)(g * 64 + t0 + r * 2 + th) * 16 + c) * 16 + cp] = acc[r];
    }
    __syncthreads();
}
__device__ __forceinline__ void ssm_w1t(const float* lamP, const float* Bb, bf16_t* W1t, int G, int bid, int wave_s) {
    int tid_ = wave_s * 64 + my_lane(); asm volatile("" : "+v"(tid_));
    const int gt = bid * 512 + tid_, NGT = G * 512;
    for (int e0 = gt; e0 < 64 * 128 * 128; e0 += 2 * NGT) {
        f32x2 lm[2]; f32x4 b0[2][2], b1[2][2];
#pragma unroll
        for (int h = 0; h < 2; ++h) {
            const int e = e0 + h * NGT, k8 = e & 127, n = (e >> 7) & 127, g = e >> 14, p = n >> 1, j = k8 >> 1, c0 = (k8 & 1) * 8;
            if (e < 64 * 128 * 128) {
                lm[h] = *(const f32x2*)(lamP + ((size_t)(g * 64 + p) * 65 + (63 - j)) * 2);
                const float* bp = Bb + ((size_t)(g * 64 + p) * 16 + c0) * 2;
                b0[h][0] = *(const f32x4*)bp; b0[h][1] = *(const f32x4*)(bp + 4); b1[h][0] = *(const f32x4*)(bp + 8); b1[h][1] = *(const f32x4*)(bp + 12);
            }
        }
#pragma unroll
        for (int h = 0; h < 2; ++h) {
            const int e = e0 + h * NGT, k8 = e & 127, n = (e >> 7) & 127, g = e >> 14, ri = n & 1;
            if (e < 64 * 128 * 128) {
                const f32x4 q0 = b0[h][0], q1 = b0[h][1], q2 = b1[h][0], q3 = b1[h][1];
                const float br[8] = {q0[0], q0[2], q1[0], q1[2], q2[0], q2[2], q3[0], q3[2]}, bi[8] = {q0[1], q0[3], q1[1], q1[3], q2[1], q2[3], q3[1], q3[3]};
                float v[8];
#pragma unroll
                for (int q = 0; q < 8; ++q) v[q] = ri ? (lm[h].x * bi[q] + lm[h].y * br[q]) : (lm[h].x * br[q] - lm[h].y * bi[q]);
                u32x4 w; w.x = cvt_pk_bf16(v[0], v[1]); w.y = cvt_pk_bf16(v[2], v[3]); w.z = cvt_pk_bf16(v[4], v[5]); w.w = cvt_pk_bf16(v[6], v[7]);
                *(u32x4*)(W1t + ((size_t)(g * 128 + n) * 1024) + k8 * 8) = w;
            }
        }
    }
}
__device__ __forceinline__ void ssm_toep(const float* cre, const float* cim, const float* lamP, const float* Ktab, bf16_t* T, int tri, int G, int bid, int wave_s) {
    int tid_ = wave_s * 64 + my_lane(); asm volatile("" : "+v"(tid_));
    const int gt = bid * 512 + tid_, NGT = G * 512;
    const int lane_ = gt & 63, gw_ = gt >> 6, NGW_ = NGT >> 6;
    for (int r0 = gw_ * 4; r0 < 64 * 1024; r0 += NGW_ * 4) {
        f32x4 a0[8], a1[8];
#pragma unroll
        for (int j = 0; j < 8; ++j) {
            const int gn = r0 + (j >> 1), k8 = 16 + ((lane_ + 64 * j) & 127), g = gn >> 10, n = gn & 1023, t = n >> 4, c = n & 15, jj = (k8 - 16) >> 1, c0 = (k8 & 1) * 8;
            a0[j] = (f32x4){0.f, 0.f, 0.f, 0.f}; a1[j] = (f32x4){0.f, 0.f, 0.f, 0.f};
            if (jj <= t) { const float* kp = Ktab + ((size_t)(g * 64 + (t - jj)) * 16 + c) * 16 + c0; a0[j] = *(const f32x4*)kp; a1[j] = *(const f32x4*)(kp + 4); }
        }
        const int gnb = r0 + (lane_ >> 4), k8b = lane_ & 15, gb = gnb >> 10, nb = gnb & 1023, tb = nb >> 4, cb = nb & 15, p0 = k8b * 4;
        const f32x4 crv = *(const f32x4*)(cre + (gb * 16 + cb) * 64 + p0), civ = *(const f32x4*)(cim + (gb * 16 + cb) * 64 + p0);
        f32x2 lm[4];
#pragma unroll
        for (int q = 0; q < 4; ++q) lm[q] = *(const f32x2*)(lamP + ((size_t)(gb * 64 + p0 + q) * 65 + (tb + 1)) * 2);
#pragma unroll
        for (int j = 0; j < 8; ++j) {
            const int gn = r0 + (j >> 1), k8 = 16 + ((lane_ + 64 * j) & 127), t = (gn & 1023) >> 4;
            if (tri && k8 >= 16 + 32 * ((t >> 4) + 1)) continue;
            u32x4 w; w.x = cvt_pk_bf16(a0[j][0], a0[j][1]); w.y = cvt_pk_bf16(a0[j][2], a0[j][3]); w.z = cvt_pk_bf16(a1[j][0], a1[j][1]); w.w = cvt_pk_bf16(a1[j][2], a1[j][3]);
            *(u32x4*)(T + (size_t)gn * KT + k8 * 8) = w;
        }
        {
            float v[8];
#pragma unroll
            for (int q = 0; q < 4; ++q) { v[2 * q] = crv[q] * lm[q].x - civ[q] * lm[q].y; v[2 * q + 1] = -(crv[q] * lm[q].y + civ[q] * lm[q].x); }
            u32x4 w; w.x = cvt_pk_bf16(v[0], v[1]); w.y = cvt_pk_bf16(v[2], v[3]); w.z = cvt_pk_bf16(v[4], v[5]); w.w = cvt_pk_bf16(v[6], v[7]);
            *(u32x4*)(T + (size_t)gnb * KT + k8b * 8) = w;
        }
    }
}
__device__ __forceinline__ void scan_one(const float* DS, const float* lamP, bf16_t* U, const float* sre, const float* sim, float* orep, float* oimp, float* ores, float* oims, int p, int g, int b, int smp) {
    const f32x2 l64 = *(const f32x2*)(lamP + ((size_t)(g * 64 + p) * 65 + 64) * 2);
    const int oidx = (b * 64 + g) * 64 + p;
    if (!smp) {
        float sr = 0.f, si = 0.f;
        const size_t r0 = (size_t)(g * NBC + b * 64);
#pragma unroll 1
        for (int c0 = 0; c0 < 64; c0 += 16) {
            f32x2 d[16];
#pragma unroll
            for (int q = 0; q < 16; ++q) d[q] = *(const f32x2*)(DS + (r0 + c0 + q) * 128 + 2 * p);
#pragma unroll
            for (int q = 0; q < 16; ++q) {
                *(unsigned*)(U + (r0 + c0 + q) * KT + 2 * p) = cvt_pk_bf16(sr, si);
                const float nr = l64.x * sr - l64.y * si + d[q].x, ni = l64.x * si + l64.y * sr + d[q].y; sr = nr; si = ni;
            }
        }
        orep[oidx] = sr; oimp[oidx] = si;
    } else {
        const float sr = sre[oidx], si = sim[oidx];
        const size_t r = (size_t)(g * NBC + 512 + b);
        *(unsigned*)(U + r * KT + 2 * p) = cvt_pk_bf16(sr, si);
        const f32x2 d = *(const f32x2*)(DS + r * 128 + 2 * p);
        ores[oidx] = l64.x * sr - l64.y * si + d.x; oims[oidx] = l64.x * si + l64.y * sr + d.y;
    }
}
__device__ __forceinline__ void ssm_scan(const float* DS, const float* lamP, bf16_t* U, const float* sre, const float* sim, float* orep, float* oimp, float* ores, float* oims, int G, int bid, int wave_s) {
    int tid_ = wave_s * 64 + my_lane(); asm volatile("" : "+v"(tid_));
    const int gt = bid * 512 + tid_, NGT = G * 512;
    for (int w = gt; w < 2 * 8 * 64 * 64; w += NGT) scan_one(DS, lamP, U, sre, sim, orep, oimp, ores, oims, w & 63, (w >> 6) & 63, (w >> 12) & 7, w >> 15);
}
__device__ __forceinline__ void ssm_scan_local(const float* DS, const float* lamP, bf16_t* U, const float* sre, const float* sim, float* orep, float* oimp, float* ores, float* oims, int g, int pm, int wave_s) {
    int tid_ = wave_s * 64 + my_lane(); asm volatile("" : "+v"(tid_));
    if (pm < 2) { if (tid_ < 256) scan_one(DS, lamP, U, sre, sim, orep, oimp, ores, oims, tid_ & 63, g, 4 * pm + (tid_ >> 6), 0); }
    else scan_one(DS, lamP, U, sre, sim, orep, oimp, ores, oims, tid_ & 63, g, tid_ >> 6, 1);
}


constexpr size_t WS_BAR = WS_CNT + 65536;
#define XB_TMO      128
#define XB_XCNT(j)  (256  + 64 * (j))
#define XB_XSUB(j)  (1280 + 64 * (j))
#define XB_XGEN(j)  (2304 + 64 * (j))
#define XB_TOP      3328
#define XB_TOPGEN   3392
#define XCD_BAR_WORDS 3456
#define XB_SPIN_CAP (1u << 22)
__device__ __forceinline__ unsigned xb_ld(unsigned* p)              { return __hip_atomic_load(p, __ATOMIC_RELAXED, __HIP_MEMORY_SCOPE_AGENT); }
__device__ __forceinline__ unsigned xb_add(unsigned* p, unsigned v) { return __hip_atomic_fetch_add(p, v, __ATOMIC_RELAXED, __HIP_MEMORY_SCOPE_AGENT); }
__device__ __forceinline__ unsigned xb_xcc_id() { return (unsigned)__builtin_amdgcn_s_getreg((3 << 11) | 20) & 0xFu; }
#define XB_SPIN(cond, bar) do { unsigned _sp = 0; while (cond) { __builtin_amdgcn_s_sleep(1); \
    if ((++_sp & 255u) == 0u) { if (xb_ld(&(bar)[XB_TMO])) break; if (_sp > XB_SPIN_CAP) { atomicAdd(&(bar)[XB_TMO], 1u); break; } } } } while (0)
__device__ __forceinline__ void xcd_barrier_complete(unsigned* bar, unsigned x, unsigned G, unsigned& nloc, unsigned& nx) {
    unsigned sum, cnt, mine, sp = 0u;
    for (;;) {
        sum = 0u; cnt = 0u; mine = 0u;
#pragma unroll
        for (unsigned j = 0; j < 16; ++j) { const unsigned c = xb_ld(&bar[XB_XCNT(j)]); sum += c; cnt += (c > 0u) ? 1u : 0u; mine = (j == x) ? c : mine; }
        if (sum == G) break;
        __builtin_amdgcn_s_sleep(1);
        if ((++sp & 255u) == 0u) { if (xb_ld(&bar[XB_TMO])) break; if (sp > XB_SPIN_CAP) { atomicAdd(&bar[XB_TMO], 1u); break; } }
    }
    nloc = mine > 0u ? mine : 1u; nx = cnt > 0u ? cnt : 1u;
}
__device__ __forceinline__ void xcd_barrier(unsigned* bar, volatile LAS unsigned* st, bool leader, unsigned G) {
    asm volatile("s_waitcnt vmcnt(0)" ::: "memory");
    __syncthreads();
    if (leader) {
        __builtin_amdgcn_s_waitcnt(0);
        const unsigned x = xb_xcc_id();
        unsigned nloc = st[0], nx = st[1];
        if (nloc == 0u) { xcd_barrier_complete(bar, x, G, nloc, nx); st[0] = nloc; st[1] = nx; }
        const unsigned old = xb_add(&bar[XB_XSUB(x)], 1u);
        const unsigned gen = old / nloc;
        if (old + 1u == (gen + 1u) * nloc) {
            __builtin_amdgcn_fence(__ATOMIC_RELEASE, "agent");
            asm volatile("s_waitcnt vmcnt(0)" ::: "memory");
            const unsigned og = xb_add(&bar[XB_TOP], 1u);
            const unsigned tg = og / nx;
            if (og + 1u == (tg + 1u) * nx) xb_add(&bar[XB_TOPGEN], 1u);
            else XB_SPIN(xb_ld(&bar[XB_TOPGEN]) == tg, bar);
            __builtin_amdgcn_fence(__ATOMIC_ACQUIRE, "agent");
            xb_add(&bar[XB_XGEN(x)], 1u);
            asm volatile("s_waitcnt vmcnt(0)" ::: "memory");
        } else {
            XB_SPIN(xb_ld(&bar[XB_XGEN(x)]) == gen, bar);
            __builtin_amdgcn_fence(__ATOMIC_ACQUIRE, "agent");
            asm volatile("s_waitcnt vmcnt(0)" ::: "memory");
        }
    }
    __syncthreads();
}

constexpr int LDS_BYTES = 144 * 1024;

__global__ void __launch_bounds__(512, 2) mega_fwd(Args a) {
    extern __shared__ __attribute__((aligned(16))) unsigned char lds_raw[];
    LAS unsigned char* lds = (LAS unsigned char*)lds_raw;
    cg::grid_group grid = cg::this_grid();
    const int wave_s = __builtin_amdgcn_readfirstlane((int)threadIdx.x >> 6);
    volatile LAS unsigned* bar_st = (volatile LAS unsigned*)(lds + 131072 + 12288);
    unsigned* const bar_words = (unsigned*)(a.ws + WS_BAR);
    {
        const int t0 = threadIdx.x;
        if (t0 < 2) bar_st[t0] = 0u;
        if (blockIdx.x == 0) for (int e = t0; e < XCD_BAR_WORDS; e += 512) __hip_atomic_store(bar_words + e, 0u, __ATOMIC_RELAXED, __HIP_MEMORY_SCOPE_AGENT);
        grid.sync();
        if (t0 == 0) (void)xb_add(&bar_words[XB_XCNT(xb_xcc_id())], 1u);
    }
    int ph = 0;
#define PH_BEGIN if (ph >= a.ph_lo && ph < a.ph_hi) { size_t zo_ = 0; asm volatile("" : "+s"(zo_));   \
        unsigned char* ws = a.ws + zo_; float* X = (float*)((unsigned char*)a.out + zo_); int G = gridDim.x, bid = blockIdx.x; \
        asm volatile("" : "+s"(G), "+s"(bid), "+s"(layer)); const int l = layer >> 1; (void)l; \
        bf16_t* XN = (bf16_t*)(ws + WS_XN); bf16_t* Hb = (bf16_t*)(ws + WS_H); (void)XN; (void)Hb; float* OUT = X; (void)OUT;
#define PH_END if (ph + 1 < a.ph_hi) xcd_barrier(bar_words, bar_st, wave_s == 0 && my_lane() == 0, (unsigned)G); } ++ph;
#define ATT_PTRS bf16_t* Qb = (bf16_t*)(ws + WS_Q); bf16_t* Ob = (bf16_t*)(ws + WS_O); bf16_t* Kb = (bf16_t*)(ws + WS_K); bf16_t* Vb = (bf16_t*)(ws + WS_V); \
        bf16_t* KS = (bf16_t*)(ws + WS_KS) + (size_t)l * 8 * 192 * 128; bf16_t* VS = (bf16_t*)(ws + WS_VS) + (size_t)l * 8 * 192 * 128; (void)Qb; (void)Ob; (void)Kb; (void)Vb; (void)KS; (void)VS;
#define SSM_PTRS bf16_t* U = (bf16_t*)(ws + WS_U); bf16_t* ZG = (bf16_t*)(ws + WS_ZG); float* DS = (float*)(ws + WS_DS); \
        bf16_t* T = (bf16_t*)(ws + WS_T); bf16_t* W1t = (bf16_t*)(ws + WS_W1T); float* Ktab = (float*)(ws + WS_KTAB); \
        const float* lamP = (const float*)(ws + WS_LAMP) + (size_t)l * 64 * 64 * 65 * 2; const float* Bb = (const float*)(ws + WS_BB) + (size_t)l * 64 * 64 * 16 * 2; \
        const float* cre = a.in[I_CRE] + (size_t)l * 65536; const float* cim = a.in[I_CIM] + (size_t)l * 65536; \
        (void)U; (void)ZG; (void)DS; (void)T; (void)W1t; (void)Ktab; (void)lamP; (void)Bb; (void)cre; (void)cim;

    { int layer = 0;
    PH_BEGIN
#ifndef SKIP_PRO
        prologue(a, lds, G, bid, wave_s);
#endif
    PH_END }

#define DEFERRED_DOWN() do { const int pl = layer - 1; \
        pg8::Gemm gd{Hb, (const bf16_t*)(ws + WS_WDN) + (size_t)pl * D * DFF, DFF, DFF, DFF, 0, 0}; pg8::OneUnit Sd{128 + ((bid - 248) >> 2), (bid - 248) & 3}; \
        EpiResidLN<false> Ed{nullptr, X, XN, LnX{(unsigned long long*)(ws + WS_XBUF), (unsigned)(pl * 2 + 2), a.in[I_LNG] + (size_t)(pl * 2 + 1) * D, a.in[I_LNB] + (size_t)(pl * 2 + 1) * D, lds + 131072}}; \
        pg8::gemm_phase(lds, gd, Sd, Ed, wave_s); \
        asm volatile("s_waitcnt vmcnt(0)" ::: "memory"); __syncthreads(); \
        if (wave_s == 0) { __builtin_amdgcn_fence(__ATOMIC_RELEASE, "agent"); asm volatile("s_waitcnt vmcnt(0)" ::: "memory"); \
                           if (my_lane() == 0) __hip_atomic_fetch_add((unsigned*)(ws + WS_CNT) + layer, 1u, __ATOMIC_RELAXED, __HIP_MEMORY_SCOPE_AGENT); } } while (0)
#define WAIT_DEFERRED_DOWN() do { if (wave_s == 0) { unsigned sp_ = 0; \
            while ((unsigned)__builtin_amdgcn_readfirstlane(__hip_atomic_load((unsigned*)(ws + WS_CNT) + layer, __ATOMIC_RELAXED, __HIP_MEMORY_SCOPE_AGENT)) < 8u) { __builtin_amdgcn_s_sleep(2); if (++sp_ > (1u << 20)) break; } \
            __builtin_amdgcn_fence(__ATOMIC_ACQUIRE, "agent"); } \
        asm volatile("s_waitcnt vmcnt(0) lgkmcnt(0)" ::: "memory"); __syncthreads(); } while (0)
    for (int layer = 0; layer < 4; ++layer) {
        if ((layer & 1) == 0) {
            PH_BEGIN { ATT_PTRS
                const int defer = (G == 256 && layer > 0) ? 1 : 0;
                if (defer && bid >= 248) { DEFERRED_DOWN(); }
                else {
                pg8::Gemm g{XN, (const bf16_t*)(ws + WS_WQKV) + (size_t)l * NQKV * D, D, D, D, 0, 0}; pg8::StaticOrder S; S.init(defer ? MP : MT, NQKV, defer ? 248 : G, bid);
                EpiQKV E{a.in[I_BQKV] + l * NQKV, (const float*)(ws + WS_ROPE), Qb, Kb, Vb, KS, VS, OUT + O_KP + (size_t)l * 131072, OUT + O_VP + (size_t)l * 131072,
                         OUT + O_KSM + (size_t)l * 131072, OUT + O_VSM + (size_t)l * 131072};
#ifndef SKIP_QKV
                pg8::gemm_phase(lds, g, S, E, wave_s);
                if (defer && bid >= 144 && bid < 154) {
                    WAIT_DEFERRED_DOWN();
                    pg8::OneUnit S2{128 + (bid - 144) / 5, (bid - 144) % 5};
                    pg8::gemm_phase(lds, g, S2, E, wave_s);
                }
#endif
                }
            } PH_END
            PH_BEGIN { ATT_PTRS
#ifndef SKIP_ATT
                attn_phase(lds, Qb, Kb, Vb, KS, VS, Ob, a.in[I_SINK] + l * 16, G, bid, wave_s);
#endif
            } PH_END
            PH_BEGIN { ATT_PTRS
                pg8::Gemm g{Ob, (const bf16_t*)(ws + WS_WO) + (size_t)l * D * D, D, D, D, 0, 0}; pg8::PanelOrder S; S.init(MT, D, G, bid);
                EpiResidLN<false> E{a.in[I_BO] + l * D, X, XN,
                             LnX{(unsigned long long*)(ws + WS_XBUF), (unsigned)(layer * 2 + 1), a.in[I_LNG] + (size_t)(layer * 2) * D, a.in[I_LNB] + (size_t)(layer * 2) * D, lds + 131072}};
#ifndef SKIP_WO
                pg8::gemm_phase(lds, g, S, E, wave_s);
#endif
            } PH_END
        } else {
            PH_BEGIN { SSM_PTRS
                const int defer = (G == 256) ? 1 : 0;
                if (defer && bid >= 248) { DEFERRED_DOWN(); }
                else {
                pg8::Gemm g{XN, (const bf16_t*)(ws + WS_WIN) + (size_t)l * D * D, D, D, D, 0, 0}; pg8::StaticOrder S; S.init(defer ? MP : MT, D, defer ? 248 : G, bid);
                EpiSsmIn E{a.in[I_BIN] + l * D, U};
#ifndef SKIP_IN
                pg8::gemm_phase(lds, g, S, E, wave_s);
                if (defer && bid >= 16 && bid < 24) {
                    WAIT_DEFERRED_DOWN();
                    pg8::OneUnit S2{128 + ((bid - 16) >> 2), (bid - 16) & 3};
                    pg8::gemm_phase(lds, g, S2, E, wave_s);
                }
#endif
                }
                ssm_ktab(lds, cre, cim, lamP, Bb, Ktab, G, bid, wave_s);
                ssm_w1t(lamP, Bb, W1t, G, bid, wave_s);
            } PH_END
            PH_BEGIN { SSM_PTRS
                pg8::Gemm g{U + 128, W1t, 1024, KT, 1024, (size_t)NBC * KT, (size_t)128 * 1024}; pg8::GroupOrder S; S.init(3, 1, 64, G, bid, 0);
                EpiDS E{DS};
#ifndef SKIP_DS
                pg8::gemm_phase(lds, g, S, E, wave_s);
#endif
                if (G == 256) {
                    const int vc = (bid & 7) * 32 + (bid >> 3);
                    if (vc < 192) ssm_scan_local(DS, lamP, U, a.in[I_SRE] + (size_t)l * 32768, a.in[I_SIM] + (size_t)l * 32768, OUT + O_REP + (size_t)l * 32768, OUT + O_IMP + (size_t)l * 32768,
                                                 OUT + O_RES + (size_t)l * 32768, OUT + O_IMS + (size_t)l * 32768, vc / 3, vc % 3, wave_s);
                }
                if (G == 256) {
                    const int vc = (bid & 7) * 32 + (bid >> 3);
                    if (vc < 192) ssm_toep(cre, cim, lamP, Ktab, T, 1, 320, vc, wave_s);
                    else { ssm_toep(cre, cim, lamP, Ktab, T, 1, 320, 192 + 2 * (vc - 192), wave_s); ssm_toep(cre, cim, lamP, Ktab, T, 1, 320, 193 + 2 * (vc - 192), wave_s); }
                } else ssm_toep(cre, cim, lamP, Ktab, T, 0, G, bid, wave_s);
            } PH_END
            if ((int)gridDim.x != 256) { PH_BEGIN { SSM_PTRS
                ssm_scan(DS, lamP, U, a.in[I_SRE] + (size_t)l * 32768, a.in[I_SIM] + (size_t)l * 32768, OUT + O_REP + (size_t)l * 32768, OUT + O_IMP + (size_t)l * 32768,
                         OUT + O_RES + (size_t)l * 32768, OUT + O_IMS + (size_t)l * 32768, G, bid, wave_s);
            } PH_END }
            PH_BEGIN { SSM_PTRS
                pg8::Gemm g{U, T, KT, KT, KT, (size_t)NBC * KT, (size_t)1024 * KT}; pg8::GroupOrder S; S.init(3, 4, 64, G, bid, G == 256 ? 1 : 0);
                EpiToep E{U, a.in[I_SD] + l * D, ZG};
#ifndef SKIP_TOEP
                pg8::gemm_phase(lds, g, S, E, wave_s);
#endif
            } PH_END
            PH_BEGIN { SSM_PTRS
                pg8::Gemm g{ZG, (const bf16_t*)(ws + WS_WGLU) + (size_t)l * 2 * D * D, D, D, D, 0, 0}; pg8::PanelOrder S; S.init(MT, 2 * D, G, bid);
                EpiGLULN E{a.in[I_BGLU] + l * 2 * D, XN,
                           LnX{(unsigned long long*)(ws + WS_XBUF), (unsigned)(layer * 2 + 1), a.in[I_LNG] + (size_t)(layer * 2) * D, a.in[I_LNB] + (size_t)(layer * 2) * D, lds + 131072}};
#ifndef SKIP_GLU
                pg8::gemm_phase(lds, g, S, E, wave_s);
#endif
            } PH_END
        }
        PH_BEGIN {
            const int defer3 = (G == 256 && layer == 3) ? 1 : 0;
            unsigned* upcnt = (unsigned*)(ws + WS_CNT) + 16;
            if (defer3 && bid >= 248) {
                if (wave_s == 0) { unsigned sp_ = 0;
                    while ((unsigned)__builtin_amdgcn_readfirstlane(__hip_atomic_load(upcnt, __ATOMIC_RELAXED, __HIP_MEMORY_SCOPE_AGENT)) < 44u) { __builtin_amdgcn_s_sleep(4); if (++sp_ > (1u << 20)) break; }
                    __builtin_amdgcn_fence(__ATOMIC_ACQUIRE, "agent"); }
                asm volatile("s_waitcnt vmcnt(0) lgkmcnt(0)" ::: "memory"); __syncthreads();
                pg8::Gemm gd{Hb, (const bf16_t*)(ws + WS_WDN) + (size_t)layer * D * DFF, DFF, DFF, DFF, 0, 0}; pg8::OneUnit Sd{128 + ((bid - 248) >> 2), (bid - 248) & 3};
                EpiResidLN<true> Ed{nullptr, X, XN, LnX{(unsigned long long*)(ws + WS_XBUF), (unsigned)(layer * 2 + 2), a.in[I_LNG] + (size_t)(layer * 2 + 1) * D, a.in[I_LNB] + (size_t)(layer * 2 + 1) * D, lds + 131072}};
#ifndef SKIP_DN
                pg8::gemm_phase(lds, gd, Sd, Ed, wave_s);
#endif
            } else {
            pg8::Gemm g{XN, (const bf16_t*)(ws + WS_WUP) + (size_t)layer * NUP * D, D, D, D, 0, 0};
            pg8::PrefixOrder S; S.base.init(defer3 ? MP : MT, NUP, defer3 ? 248 : G, bid); S.has = (defer3 && bid >= 88 && bid < 132) ? 1 : 0; S.pm = 128 + (bid - 88) / 22; S.pn = (bid - 88) % 22;
            EpiSwiGLU E{Hb, defer3 ? upcnt : nullptr};
#ifndef SKIP_UP
            pg8::gemm_phase(lds, g, S, E, wave_s);
#endif
            }
        } PH_END
        PH_BEGIN {
            pg8::Gemm g{Hb, (const bf16_t*)(ws + WS_WDN) + (size_t)layer * D * DFF, DFF, DFF, DFF, 0, 0}; pg8::PanelOrder S; S.init((G == 256) ? MP : MT, D, G, bid);
            const LnX LX = LnX{(unsigned long long*)(ws + WS_XBUF), (unsigned)(layer * 2 + 2), a.in[I_LNG] + (size_t)(layer * 2 + 1) * D, a.in[I_LNB] + (size_t)(layer * 2 + 1) * D, lds + 131072};
#ifndef SKIP_DN
            if (layer == 3) { EpiResidLN<true> E{nullptr, X, XN, LX}; pg8::gemm_phase(lds, g, S, E, wave_s); }
            else { EpiResidLN<false> E{nullptr, X, XN, LX}; pg8::gemm_phase(lds, g, S, E, wave_s); }
#endif
        } PH_END
    }
}

extern "C" void kernel_launch(void* const* d_in, const int* in_sizes, int n_in, void* d_out, int out_size, void* d_ws, size_t ws_size, hipStream_t stream) {
    static int grid = 0;
    if (grid == 0) {
        if (n_in != N_IN || ws_size < WS_END2) { fprintf(stderr, "kernel_launch: unexpected n_in %d / ws_size %zu\n", n_in, ws_size); grid = -1; return; }
        int dev = 0, cus = 0, per_cu = 0;
        hipGetDevice(&dev); hipDeviceGetAttribute(&cus, hipDeviceAttributeMultiprocessorCount, dev);
        if (hipFuncSetAttribute((const void*)mega_fwd, hipFuncAttributeMaxDynamicSharedMemorySize, LDS_BYTES) != hipSuccess) { fprintf(stderr, "kernel_launch: hipFuncSetAttribute failed\n"); grid = -1; return; }
        hipOccupancyMaxActiveBlocksPerMultiprocessor(&per_cu, (const void*)mega_fwd, 512, LDS_BYTES);
        (void)hipGetLastError();
        if (per_cu < 1) fprintf(stderr, "kernel_launch: occupancy query says %d blocks per CU\n", per_cu);
        grid = cus > 0 ? cus : 256;
    }
    if (grid < 0) return;
    Args a{};
    for (int i = 0; i < N_IN; ++i) a.in[i] = (const float*)d_in[i];
    a.out = (float*)d_out; a.ws = (unsigned char*)d_ws; a.ph_lo = 0; a.ph_hi = 1000;
    void* args[] = {&a};
    hipError_t e = hipLaunchCooperativeKernel((const void*)mega_fwd, dim3(grid), dim3(512), args, LDS_BYTES, stream);
    if (e != hipSuccess) fprintf(stderr, "cooperative launch failed: %s (grid %d)\n", hipGetErrorString(e), grid);
}
```
